# Optimizing an MI355X kernel written in HIP

```python
import jax, jax.numpy as jnp
from jax import lax
import numpy as np

D_MODEL = 2048
BATCH = 4
SEQ = 2048
DEPTH = 1
DEC_BATCH = 128
DEC_SEQ = 8
PAST_LEN = 16384
PAGE_SIZE = 128

N_META = 16
D_HALF = D_MODEL // 2
DK_A = 128
DV_A = 128
H_A = D_HALF // DV_A
H_B = 4
DV_B = D_HALF // H_B
DK_B = DV_B // 2
ALPHA_RANK = 16
GATE_TEMP = 16.0
D_MIX = H_A * DV_A + H_B * DV_B
D_FF = 5632
CHUNK = 64
EPS = 1e-6
PROJ_WIDTHS = (H_A * DK_A, H_A * DK_A, H_A * DV_A, H_A * DV_A,
               H_B * DK_B, H_B * DK_B, H_B * DV_B, H_B * DV_B, ALPHA_RANK)
D_IN_PROJ = sum(PROJ_WIDTHS)
SPLIT_IDX = [int(v) for v in np.cumsum(PROJ_WIDTHS)[:-1]]

kernel_name = "hymba_hgrn2_gla_macaron_step"


def rmsnorm(x, w):
    xf = x.astype(jnp.float32)
    y = xf * lax.rsqrt(jnp.mean(xf * xf, axis=-1, keepdims=True) + EPS)
    return (y * w.astype(jnp.float32)).astype(x.dtype)


def head_rmsnorm(o, w):
    y = o * lax.rsqrt(jnp.mean(o * o, axis=-1, keepdims=True) + EPS)
    b, t = o.shape[:2]
    return y.reshape(b, t, -1) * w.astype(jnp.float32)


def swiglu(h, norm_w, w_in, w_out):
    u = rmsnorm(h, norm_w)
    g, up = jnp.split(u @ w_in, 2, axis=-1)
    return (jax.nn.silu(g) * up) @ w_out


def gated_linear_scan(q, k, v, logg, S0):
    b, t, h, dk = q.shape
    dv = v.shape[-1]
    c = min(CHUNK, t)
    n = -(-t // c)
    pad = n * c - t
    padf = lambda a: jnp.pad(a, ((0, 0), (0, pad), (0, 0), (0, 0)))
    to_chunks = lambda a: padf(a).reshape(b, n, c, h, a.shape[-1]).transpose(1, 0, 2, 3, 4)
    mask = jnp.tril(jnp.ones((c, c), dtype=bool))[None, :, :, None, None]

    def step(S, inp):
        qc, kc, vc, gc = inp
        Bc = jnp.cumsum(gc, axis=1)
        o_inter = jnp.einsum('bthk,bhkv->bthv', qc * jnp.exp(Bc), S)
        diff = Bc[:, :, None] - Bc[:, None, :]
        decay = jnp.exp(jnp.where(mask, diff, -jnp.inf))
        A = jnp.einsum('bthk,bshk,btshk->bhts', qc, kc, decay)
        o_intra = jnp.einsum('bhts,bshv->bthv', A, vc)
        Blast = Bc[:, -1]
        kdec = kc * jnp.exp(Blast[:, None] - Bc)
        S_new = jnp.exp(Blast)[..., None] * S + jnp.einsum('bshk,bshv->bhkv', kdec, vc)
        return S_new, o_inter + o_intra

    S, o = lax.scan(step, S0.astype(jnp.float32), (to_chunks(q), to_chunks(k), to_chunks(v), to_chunks(logg)))
    o = o.transpose(1, 0, 2, 3, 4).reshape(b, n * c, h, dv)[:, :t]
    return o, S


def segmented_scan(q, k, v, logg, S0, seg_lens):
    outs, S, start = [], S0, 0
    for L in seg_lens:
        sl = slice(start, start + L)
        o, S = gated_linear_scan(q[:, sl], k[:, sl], v[:, sl], logg[:, sl], S)
        outs.append(o)
        start += L
    return jnp.concatenate(outs, axis=1), S


def token_mix(u, S_a0, S_b0, seg_lens, lb, w_in, w_alpha_up, b_alpha, gn_a, gn_b, w_out):
    b, t, _ = u.shape
    f32 = jnp.float32
    q_a, f_a, i_a, g_a, q_b, k_b, v_b, r_b, a_low = jnp.split(u @ w_in, SPLIT_IDX, axis=-1)
    heads = lambda a, h: a.astype(f32).reshape(b, t, h, -1)
    lbh = lb.reshape(H_A, DK_A)
    fg = lbh + (1.0 - lbh) * jax.nn.sigmoid(heads(f_a, H_A))
    qa = heads(jax.nn.silu(q_a), H_A) * (DK_A ** -0.5)
    o_a, S_a = segmented_scan(qa, 1.0 - fg, heads(i_a, H_A), jnp.log(fg), S_a0, seg_lens)
    logg_b = heads(jax.nn.log_sigmoid((a_low @ w_alpha_up + b_alpha).astype(f32)) / GATE_TEMP, H_B)
    qb = heads(q_b, H_B) * (DK_B ** -0.5)
    o_b, S_b = segmented_scan(qb, heads(k_b, H_B), heads(v_b, H_B), logg_b, S_b0, seg_lens)
    o_a = head_rmsnorm(o_a, gn_a) * jax.nn.silu(g_a.astype(f32))
    o_b = head_rmsnorm(o_b, gn_b) * jax.nn.silu(r_b.astype(f32))
    o = jnp.concatenate([o_a, o_b], axis=-1).astype(u.dtype)
    return o @ w_out, S_a, S_b


def trunk(h, states_a, states_b, seg_lens, lb_logits,
          ffn1_norm, w_ffn1_in, w_ffn1_out, mix_norm, w_in, w_alpha_up, b_alpha, gnorm_a, gnorm_b, w_out,
          ffn2_norm, w_ffn2_in, w_ffn2_out, final_norm):
    lbs = jnp.cumsum(jax.nn.softmax(lb_logits.astype(jnp.float32), axis=0), axis=0)
    new_a, new_b = [], []
    for l in range(DEPTH):
        h = h + 0.5 * swiglu(h, ffn1_norm[l], w_ffn1_in[l], w_ffn1_out[l])
        m, Sa, Sb = token_mix(rmsnorm(h, mix_norm[l]), states_a[l], states_b[l], seg_lens, lbs[l],
                              w_in[l], w_alpha_up[l], b_alpha[l], gnorm_a[l], gnorm_b[l], w_out[l])
        h = h + m
        h = h + 0.5 * swiglu(h, ffn2_norm[l], w_ffn2_in[l], w_ffn2_out[l])
        new_a.append(Sa)
        new_b.append(Sb)
    return rmsnorm(h, final_norm), jnp.stack(new_a), jnp.stack(new_b)


def setup_inputs(seed: int = 0) -> dict:
    key = jax.random.key(seed)
    ks = jax.random.split(key, 24)
    nrm = lambda k, shape, s: jax.random.normal(k, shape, jnp.float32) * s
    gain = lambda k, shape: 1.0 + nrm(k, shape, 0.02)
    return {
        "x_prompt": nrm(ks[0], (BATCH, SEQ, D_MODEL), 1.0),
        "x_sample": nrm(ks[1], (DEC_BATCH, DEC_SEQ, D_MODEL), 1.0),
        "state_hgrn": nrm(ks[2], (DEPTH, DEC_BATCH, H_A, DK_A, DV_A), 0.5),
        "state_gla": nrm(ks[3], (DEPTH, DEC_BATCH, H_B, DK_B, DV_B), 0.5),
        "meta_tokens": nrm(ks[4], (N_META, D_MODEL), 1.0),
        "lb_logits": nrm(ks[5], (DEPTH + 1, H_A * DK_A), 0.5),
        "ffn1_norm": gain(ks[6], (DEPTH, D_MODEL)),
        "w_ffn1_in": nrm(ks[7], (DEPTH, D_MODEL, 2 * D_FF), D_MODEL ** -0.5),
        "w_ffn1_out": nrm(ks[8], (DEPTH, D_FF, D_MODEL), D_FF ** -0.5),
        "mix_norm": gain(ks[9], (DEPTH, D_MODEL)),
        "w_in": nrm(ks[10], (DEPTH, D_MODEL, D_IN_PROJ), D_MODEL ** -0.5),
        "w_alpha_up": nrm(ks[11], (DEPTH, ALPHA_RANK, H_B * DK_B), ALPHA_RANK ** -0.5),
        "b_alpha": nrm(ks[12], (DEPTH, H_B * DK_B), 0.1),
        "gnorm_a": gain(ks[13], (DEPTH, H_A * DV_A)),
        "gnorm_b": gain(ks[14], (DEPTH, H_B * DV_B)),
        "w_out": nrm(ks[15], (DEPTH, D_MIX, D_MODEL), D_MIX ** -0.5),
        "ffn2_norm": gain(ks[16], (DEPTH, D_MODEL)),
        "w_ffn2_in": nrm(ks[17], (DEPTH, D_MODEL, 2 * D_FF), D_MODEL ** -0.5),
        "w_ffn2_out": nrm(ks[18], (DEPTH, D_FF, D_MODEL), D_FF ** -0.5),
        "final_norm": gain(ks[19], (D_MODEL,)),
    }


def reference(x_prompt, x_sample, state_hgrn, state_gla, meta_tokens, lb_logits,
              ffn1_norm, w_ffn1_in, w_ffn1_out, mix_norm, w_in, w_alpha_up, b_alpha, gnorm_a, gnorm_b, w_out,
              ffn2_norm, w_ffn2_in, w_ffn2_out, final_norm):
    weights = (lb_logits, ffn1_norm, w_ffn1_in, w_ffn1_out, mix_norm, w_in, w_alpha_up, b_alpha,
               gnorm_a, gnorm_b, w_out, ffn2_norm, w_ffn2_in, w_ffn2_out, final_norm)
    b = x_prompt.shape[0]
    meta = jnp.broadcast_to(meta_tokens.astype(x_prompt.dtype)[None], (b, N_META, D_MODEL))
    h_p = jnp.concatenate([meta, x_prompt], axis=1)
    za = jnp.zeros((DEPTH, b, H_A, DK_A, DV_A), jnp.float32)
    zb = jnp.zeros((DEPTH, b, H_B, DK_B, DV_B), jnp.float32)
    out_p, new_a_p, new_b_p = trunk(h_p, za, zb, (N_META, x_prompt.shape[1]), *weights)
    y_prompt = out_p[:, N_META:]
    y_sample, new_a_s, new_b_s = trunk(x_sample, state_hgrn, state_gla, (x_sample.shape[1],), *weights)
    return (y_prompt, y_sample, new_a_p, new_b_p, new_a_s, new_b_s)
```

```cpp
#include <hip/hip_runtime.h>
#include <hip/hip_cooperative_groups.h>
#include <cstdio>
namespace cg = cooperative_groups;

#define LAS __attribute__((address_space(3)))
typedef unsigned short bf16_t;
typedef short bf16x8 __attribute__((ext_vector_type(8)));
typedef float f32x4 __attribute__((ext_vector_type(4)));
typedef float f32x2 __attribute__((ext_vector_type(2)));
typedef unsigned u32x4 __attribute__((ext_vector_type(4)));
typedef unsigned u32x2 __attribute__((ext_vector_type(2)));

constexpr int D = 2048, DFF = 5632, NFF = 2 * DFF, NIN = 7184, NINP = 7424;
constexpr int MROWS = 9472;
constexpr int ROW_S = 8192, ROW_M = 9216, ROW_MEND = 9232;
constexpr float EPS = 1e-6f;
constexpr int NTHREADS = 512;

constexpr size_t OUT_SAP = 18874368, OUT_SBP = 19398656, OUT_SAS = 19922944, OUT_SBS = 36700160;

constexpr size_t SZ_WFI = (size_t)NFF * D * 2, SZ_WFO = (size_t)D * DFF * 2, SZ_WIN = (size_t)NINP * D * 2, SZ_WOUT = (size_t)D * D * 2;
constexpr size_t WS_W1I = 0;
constexpr size_t WS_W1O = WS_W1I + SZ_WFI;
constexpr size_t WS_WIN = WS_W1O + SZ_WFO;
constexpr size_t WS_WOUT = WS_WIN + SZ_WIN;
constexpr size_t WS_W2I = WS_WOUT + SZ_WOUT;
constexpr size_t WS_W2O = WS_W2I + SZ_WFI;
constexpr size_t WS_HB = WS_W2O + SZ_WFO;
constexpr size_t WS_ACT = WS_HB + (size_t)MROWS * D * 2;
constexpr size_t WS_QA = WS_ACT + (size_t)MROWS * DFF * 2;
constexpr size_t WS_KA = WS_QA + (size_t)MROWS * 1024 * 2;
constexpr size_t WS_VA = WS_KA + (size_t)MROWS * 1024 * 2;
constexpr size_t WS_GA = WS_VA + (size_t)MROWS * 1024 * 2;
constexpr size_t WS_LGA = WS_GA + (size_t)MROWS * 1024 * 2;
constexpr size_t WS_QB = WS_LGA + (size_t)MROWS * 1024 * 4;
constexpr size_t WS_KB = WS_QB + (size_t)MROWS * 512 * 2;
constexpr size_t WS_VB = WS_KB + (size_t)MROWS * 512 * 2;
constexpr size_t WS_RB = WS_VB + (size_t)MROWS * 1024 * 2;
constexpr size_t WS_ALOW = WS_RB + (size_t)MROWS * 1024 * 2;
constexpr size_t WS_HMETA = WS_ALOW + (size_t)MROWS * 16 * 4;
constexpr size_t WS_SQ = WS_HMETA + (size_t)256 * D * 4;
constexpr size_t WS_SS = WS_SQ + (size_t)4 * MROWS * 4;
constexpr size_t WS_LB = WS_SS + (size_t)MROWS * 16 * 4;
constexpr size_t WS_SS2 = WS_LB + 4096;
constexpr size_t WS_BAR = WS_SS2 + (size_t)MROWS * 16 * 4;
constexpr size_t WS_SSP = WS_BAR + 16384;
constexpr size_t WS_END = WS_SSP + (size_t)MROWS * 192 * 4;
constexpr size_t WS_OS = WS_HB;
constexpr size_t WS_PB = WS_VA;
constexpr size_t WS_SLOT = WS_ACT;

struct Params { const float* in[20]; float* out; unsigned char* ws; };

typedef __bf16 bf16x2_t __attribute__((ext_vector_type(2)));
__device__ __forceinline__ unsigned cvt_pk_bf16(float lo, float hi) { const f32x2 v = {lo, hi}; return __builtin_bit_cast(unsigned, __builtin_convertvector(v, bf16x2_t)); }
__device__ __forceinline__ bf16_t f2bf(float f) { unsigned u = __float_as_uint(f); u += 0x7FFFu + ((u >> 16) & 1u); return (bf16_t)(u >> 16); }
__device__ __forceinline__ float bf2f(bf16_t b) { return __uint_as_float(((unsigned)b) << 16); }
__device__ __forceinline__ float silu_f(float x) { return x * __builtin_amdgcn_rcpf(1.f + __expf(-x)); }
__device__ __forceinline__ float sigmoid_f(float x) { return __builtin_amdgcn_rcpf(1.f + __expf(-x)); }
__device__ __forceinline__ float row16_sum(float v) {
    v += __int_as_float(__builtin_amdgcn_update_dpp(0, __float_as_int(v), 0xB1, 0xF, 0xF, true));
    v += __int_as_float(__builtin_amdgcn_update_dpp(0, __float_as_int(v), 0x4E, 0xF, 0xF, true));
    v += __int_as_float(__builtin_amdgcn_update_dpp(0, __float_as_int(v), 0x141, 0xF, 0xF, true));
    v += __int_as_float(__builtin_amdgcn_update_dpp(0, __float_as_int(v), 0x140, 0xF, 0xF, true));
    return v;
}
__device__ __forceinline__ u32x4 pack8(const f32x4 a, const f32x4 b) { u32x4 w; w.x = cvt_pk_bf16(a[0], a[1]); w.y = cvt_pk_bf16(a[2], a[3]); w.z = cvt_pk_bf16(b[0], b[1]); w.w = cvt_pk_bf16(b[2], b[3]); return w; }

namespace pg8 {
constexpr int BM = 256, BK = 64, HALF = 128, HTB = HALF * BK * 2, STAGE_BYTES = 8 * HTB, NXCD = 8, WGM = 8;
__device__ __forceinline__ int lds_byte(int r, int c) { const int st = (r >> 4) * 2 + (c >> 5), rr = r & 15, cc = c & 31, ob = rr * 64 + cc * 2; return st * 1024 + (ob ^ (((ob >> 9) & 1) << 5)); }
__device__ __forceinline__ void stage_rc(int b, int& R, int& C) { const int st = b / 1024, sb = b % 1024, swz = sb ^ (((sb >> 9) & 1) << 5); R = (st >> 1) * 16 + swz / 64; C = (st & 1) * 32 + (swz % 64) / 2; }
__device__ __forceinline__ int perm32(int rho) { const int n = rho >> 4, i = rho & 15; return 8 * (i >> 2) + 4 * n + (i & 3); }
struct Unit { int pm, pn, kt0, nkt, part; };
struct Gemm { const bf16_t* A; const bf16_t* Bt; int M, N, K; };
struct StaticOrder {
    int nM, nN, nwg, G, c, nt, full, tail, S;
    __device__ __forceinline__ void init(int M, int N, int K, int G_, int c_, bool split) {
        nM = M / BM; nN = N / BM; nwg = nM * nN; G = G_; c = c_; nt = K / BK; full = nwg; tail = 0; S = 1;
        if (split) { const int f = (nwg / G) * G, tl = nwg - f; if (tl > 0 && G / tl >= 2) { full = f; tail = tl; S = G / tl; } }
    }
    __device__ __forceinline__ void map(int wgid, Unit& u) const {
        { const int q = nwg / NXCD, r = nwg % NXCD, xcd = wgid % NXCD, off = wgid / NXCD; wgid = (xcd < r ? xcd * (q + 1) : r * (q + 1) + (xcd - r) * q) + off; }
        const int nig = WGM * nN, gid = wgid / nig, fm = gid * WGM, gsz = (nM - fm) < WGM ? (nM - fm) : WGM;
        u.pm = fm + ((wgid % nig) % gsz); u.pn = (wgid % nig) / gsz;
    }
    __device__ __forceinline__ bool next(int i, Unit& u) const {
        const long L = (long)i * G + c;
        if (L < full) { map((int)L, u); u.kt0 = 0; u.nkt = nt; u.part = -1; return true; }
        if (tail > 0 && i == full / G) {
            const int np = tail * S; int q;
            if (np % NXCD == 0) { const int per = np / NXCD, x = c % NXCD, ii = c / NXCD; if (ii >= per) return false; q = x * per + ii; } else { if (c >= np) return false; q = c; }
            const int pp = q / tail, j = q - pp * tail;
            map(full + j, u);
            const int pairs = nt / 2, base = pairs / S, rem = pairs % S;
            u.kt0 = 2 * (pp * base + (pp < rem ? pp : rem)); u.nkt = 2 * (base + (pp < rem ? 1 : 0)); u.part = j * S + pp; return true;
        }
        return false;
    }
};

template <class Epi>
__device__ __forceinline__ void gemm_phase(LAS unsigned char* lds, const Gemm g, const StaticOrder& S, const Epi& E, float* pbuf = nullptr) {
    int tid_ = threadIdx.x; asm volatile("" : "+v"(tid_));
    const int tid = tid_, wid = __builtin_amdgcn_readfirstlane(tid >> 6), lane = tid & 63, wr = wid >> 2, wc = wid & 3, fr = lane & 15, fq = lane >> 4;
    const int K = g.K;
    unsigned voffA[2], voffB[2];
#pragma unroll
    for (int i = 0; i < 2; ++i) { int R, C; stage_rc(tid * 16 + i * 8192, R, C); const int Rb = (R & ~31) + perm32(R & 31);
        voffA[i] = (unsigned)(R * K + C) * 2u; voffB[i] = (unsigned)(Rb * K + C) * 2u; }
    const size_t kstep = (size_t)(BK * 2);
    const size_t hstep = (size_t)HALF * K * 2;
    const size_t tstep = 2 * hstep;
    const unsigned ldsw = (unsigned)wid * 1024u;
    const int aoff = lds_byte(wr * 64 + fr, fq * 8), boff = lds_byte(wc * 32 + fr, fq * 8);
#define PG8_SA(b, h) (((b) * 2 + (h)) * HTB)
#define PG8_SB(b, h) ((4 + (b) * 2 + (h)) * HTB)
#define PG8_STAGE(bufoff, gbase, voff) do { _Pragma("unroll") for (int _i = 0; _i < 2; ++_i) \
        __builtin_amdgcn_global_load_lds((const unsigned*)((const char*)(gbase) + (voff)[_i]), (LAS unsigned*)(lds + (bufoff) + ldsw + _i * 8192), 16, 0, 0); } while (0)
#define PG8_LDA(dst, b, h) do { _Pragma("unroll") for (int m = 0; m < 4; ++m) _Pragma("unroll") for (int k = 0; k < 2; ++k) dst[m][k] = *(const LAS bf16x8*)(lds + PG8_SA(b, h) + aoff + m * 2048 + k * 1024); } while (0)
#define PG8_LDB(dst, b, h) do { _Pragma("unroll") for (int n = 0; n < 2; ++n) _Pragma("unroll") for (int k = 0; k < 2; ++k) dst[n][k] = *(const LAS bf16x8*)(lds + PG8_SB(b, h) + boff + n * 2048 + k * 1024); } while (0)
#define PG8_MMA(ai, bj, At, Bt) do { __builtin_amdgcn_s_setprio(1); _Pragma("unroll") for (int m = 0; m < 4; ++m) _Pragma("unroll") for (int n = 0; n < 2; ++n) _Pragma("unroll") for (int k = 0; k < 2; ++k) \
        acc[ai][bj][m][n] = __builtin_amdgcn_mfma_f32_16x16x32_bf16(Bt[n][k], At[m][k], acc[ai][bj][m][n], 0, 0, 0); __builtin_amdgcn_s_setprio(0); } while (0)
#define PG8_WAIT_V(n) asm volatile("s_waitcnt vmcnt(" #n ")" ::: "memory")
#define PG8_WAIT_L(n) asm volatile("s_waitcnt lgkmcnt(" #n ")" ::: "memory")
#define PG8_BAR __builtin_amdgcn_s_barrier()
#define PG8_SCHED __builtin_amdgcn_sched_barrier(0)
    Unit cur, nxt; int ui = 0;
    if (!S.next(0, cur)) return;
    f32x4 acc[2][2][4][2];
#pragma unroll
    for (int a = 0; a < 2; ++a)
#pragma unroll
        for (int b = 0; b < 2; ++b)
#pragma unroll
            for (int m = 0; m < 4; ++m)
#pragma unroll
                for (int n = 0; n < 2; ++n) acc[a][b][m][n] = (f32x4){0.f, 0.f, 0.f, 0.f};
    bf16x8 At[4][2], B0[2][2], B1[2][2];
    float pre[8];
    E.prefetch(cur, wr, fr, pre);
    const char* cA = (const char*)g.A + (size_t)cur.pm * tstep + (size_t)cur.kt0 * kstep; const char* cB = (const char*)g.Bt + (size_t)cur.pn * tstep + (size_t)cur.kt0 * kstep;
    PG8_STAGE(PG8_SB(0, 0), cB, voffB); PG8_STAGE(PG8_SA(0, 0), cA, voffA); PG8_STAGE(PG8_SB(0, 1), cB + hstep, voffB); PG8_STAGE(PG8_SA(0, 1), cA + hstep, voffA);
    if (wr == 1) PG8_BAR;
    PG8_WAIT_V(4); PG8_BAR;
    PG8_STAGE(PG8_SB(1, 0), cB + kstep, voffB); PG8_STAGE(PG8_SA(1, 0), cA + kstep, voffA); PG8_STAGE(PG8_SB(1, 1), cB + hstep + kstep, voffB);
    PG8_WAIT_V(6); PG8_BAR;
    for (;;) {
        const bool has_next = S.next(ui + 1, nxt);
        const char* nA = has_next ? (const char*)g.A + (size_t)nxt.pm * tstep + (size_t)nxt.kt0 * kstep : cA; const char* nB = has_next ? (const char*)g.Bt + (size_t)nxt.pn * tstep + (size_t)nxt.kt0 * kstep : cB;
        const int nt = cur.nkt;
        for (int t = 0; t < nt; t += 2) {
            const bool last = (t == nt - 2);
            const char* a1 = cA + (size_t)(t + 1) * kstep;
            const char* a2 = last ? nA : cA + (size_t)(t + 2) * kstep; const char* b2 = last ? nB : cB + (size_t)(t + 2) * kstep;
            const char* a3 = a2 + kstep; const char* b3 = b2 + kstep;
            PG8_LDB(B0, 0, 0); PG8_SCHED; PG8_LDA(At, 0, 0); PG8_STAGE(PG8_SA(1, 1), a1 + hstep, voffA);
            PG8_WAIT_L(8); PG8_BAR; PG8_WAIT_L(0); PG8_MMA(0, 0, At, B0); PG8_BAR; PG8_SCHED;
            PG8_LDB(B1, 0, 1); PG8_STAGE(PG8_SB(0, 0), b2, voffB);
            PG8_BAR; PG8_WAIT_L(0); PG8_MMA(0, 1, At, B1); PG8_BAR;
            PG8_LDA(At, 0, 1); PG8_STAGE(PG8_SA(0, 0), a2, voffA);
            PG8_BAR; PG8_WAIT_L(0); PG8_MMA(1, 0, At, B0); PG8_BAR; PG8_SCHED;
            PG8_STAGE(PG8_SB(0, 1), b2 + hstep, voffB);
            PG8_WAIT_V(6); PG8_BAR; PG8_MMA(1, 1, At, B1); PG8_BAR;
            PG8_LDB(B0, 1, 0); PG8_SCHED; PG8_LDA(At, 1, 0); PG8_STAGE(PG8_SA(0, 1), a2 + hstep, voffA);
            PG8_WAIT_L(8); PG8_BAR; PG8_WAIT_L(0); PG8_MMA(0, 0, At, B0); PG8_BAR; PG8_SCHED;
            PG8_LDB(B1, 1, 1); PG8_STAGE(PG8_SB(1, 0), b3, voffB);
            PG8_BAR; PG8_WAIT_L(0); PG8_MMA(0, 1, At, B1); PG8_BAR;
            PG8_LDA(At, 1, 1); PG8_STAGE(PG8_SA(1, 0), a3, voffA);
            PG8_BAR; PG8_WAIT_L(0); PG8_MMA(1, 0, At, B0); PG8_BAR; PG8_SCHED;
            PG8_STAGE(PG8_SB(1, 1), b3 + hstep, voffB);
            PG8_WAIT_V(6); PG8_BAR; PG8_MMA(1, 1, At, B1); PG8_BAR;
        }
        if (cur.part >= 0) {
            float* pb = pbuf + (size_t)cur.part * 65536 + (size_t)wid * 8192 + lane * 4;
#pragma unroll
            for (int a = 0; a < 2; ++a)
#pragma unroll
                for (int b = 0; b < 2; ++b)
#pragma unroll
                    for (int m = 0; m < 4; ++m)
#pragma unroll
                        for (int n = 0; n < 2; ++n) *(f32x4*)(pb + (((a * 2 + b) * 4 + m) * 2 + n) * 256) = acc[a][b][m][n];
        } else E(acc, cur, wr, wc, fr, fq, pre);
        if (!has_next) break;
#pragma unroll
        for (int a = 0; a < 2; ++a)
#pragma unroll
            for (int b = 0; b < 2; ++b)
#pragma unroll
                for (int m = 0; m < 4; ++m)
#pragma unroll
                    for (int n = 0; n < 2; ++n) acc[a][b][m][n] = (f32x4){0.f, 0.f, 0.f, 0.f};
        cur = nxt; cA = nA; cB = nB; ++ui;
        E.prefetch(cur, wr, fr, pre);
    }
    PG8_WAIT_V(0);
    if (wr == 0) PG8_BAR;
    PG8_BAR;
#undef PG8_SA
#undef PG8_SB
#undef PG8_STAGE
#undef PG8_LDA
#undef PG8_LDB
#undef PG8_MMA
#undef PG8_WAIT_V
#undef PG8_WAIT_L
#undef PG8_BAR
#undef PG8_SCHED
}
}

struct EpiSwiglu {
    const float* sq; bf16_t* act;
    __device__ __forceinline__ void rowgroup(const f32x4 (&a)[2][2], int pm, int pn, int rt, int wc, int fq) const {
        const int r = pm * 256 + rt;
        const float rs = rsqrtf(sq[r] * (1.0f / D) + EPS);
        f32x4 o0, o1;
#pragma unroll
        for (int j = 0; j < 4; ++j) { o0[j] = silu_f(a[0][0][j] * rs) * (a[1][0][j] * rs); o1[j] = silu_f(a[0][1][j] * rs) * (a[1][1][j] * rs); }
        *(u32x4*)(act + (size_t)r * DFF + pn * 128 + wc * 32 + 8 * fq) = pack8(o0, o1);
    }
    __device__ __forceinline__ void prefetch(const pg8::Unit& u, int wr, int fr, float (&pre)[8]) const {
        const int row0 = u.pm * 256 + wr * 64 + fr;
#pragma unroll
        for (int i = 0; i < 8; ++i) pre[i] = sq[row0 + (i >> 2) * 128 + (i & 3) * 16];
    }
    __device__ __forceinline__ void operator()(const f32x4 (&acc)[2][2][4][2], const pg8::Unit& u, int wr, int wc, int fr, int fq, const float (&pre)[8]) const {
        asm volatile("" : "+v"(fr), "+v"(fq));
        const int row0 = u.pm * 256 + wr * 64 + fr, col0 = u.pn * 128 + wc * 32 + 8 * fq;
        float rsv[8];
#pragma unroll
        for (int i = 0; i < 8; ++i) rsv[i] = rsqrtf(pre[i] * (1.0f / D) + EPS);
#pragma unroll
        for (int ai = 0; ai < 2; ++ai)
#pragma unroll
            for (int m = 0; m < 4; ++m) {
                const int r = row0 + ai * 128 + m * 16;
                const float rs = rsv[ai * 4 + m];
                f32x4 o0, o1;
#pragma unroll
                for (int j = 0; j < 4; ++j) {
                    o0[j] = silu_f(acc[ai][0][m][0][j] * rs) * (acc[ai][1][m][0][j] * rs);
                    o1[j] = silu_f(acc[ai][0][m][1][j] * rs) * (acc[ai][1][m][1][j] * rs);
                }
                *(u32x4*)(act + (size_t)r * DFF + col0) = pack8(o0, o1);
            }
    }
};
struct EpiResid {
    float* out; float* hmeta; bf16_t* hb; float* sq; float scale; int write_hb;
    const float* xin_p; const float* xin_s;
    __device__ __forceinline__ void rowgroup(const f32x4 (&a)[2][2], int pm, int pn, int rt, int wc, int fq) const {
        float* hbase = (pm < 36) ? out + (size_t)pm * 256 * D : hmeta;
        const float* rbase = !xin_p ? hbase : (pm < 32) ? xin_p + (size_t)pm * 256 * D : (pm < 36) ? xin_s + (size_t)(pm - 32) * 256 * D : hmeta;
        const int col0 = pn * 256 + wc * 32 + 8 * fq;
        float* hp = hbase + (size_t)rt * D + col0;
        const float* rp = rbase + (size_t)rt * D + col0;
        f32x4 h[2][2];
#pragma unroll
        for (int bj = 0; bj < 2; ++bj) { h[bj][0] = __builtin_nontemporal_load((const f32x4*)(rp + bj * 128)); h[bj][1] = __builtin_nontemporal_load((const f32x4*)(rp + bj * 128 + 4)); }
        float ss = 0.f;
#pragma unroll
        for (int bj = 0; bj < 2; ++bj) {
            const f32x4 h0 = h[bj][0] + scale * a[bj][0], h1 = h[bj][1] + scale * a[bj][1];
            __builtin_nontemporal_store(h0, (f32x4*)(hp + bj * 128)); __builtin_nontemporal_store(h1, (f32x4*)(hp + bj * 128 + 4));
            ss += (h0[0] * h0[0] + h0[1] * h0[1]) + (h0[2] * h0[2] + h0[3] * h0[3]) + (h1[0] * h1[0] + h1[1] * h1[1]) + (h1[2] * h1[2] + h1[3] * h1[3]);
            if (write_hb) *(u32x4*)(hb + (size_t)(pm * 256 + rt) * D + col0 + bj * 128) = pack8(h0, h1);
        }
        ss += __shfl_xor(ss, 16); ss += __shfl_xor(ss, 32);
        if (fq == 0) atomicAdd(sq + pm * 256 + rt, ss);
    }
    __device__ __forceinline__ void prefetch(const pg8::Unit&, int, int, float (&)[8]) const {}
    __device__ __forceinline__ void operator()(const f32x4 (&acc)[2][2][4][2], const pg8::Unit& u, int wr, int wc, int fr, int fq, const float (&)[8]) const {
        asm volatile("" : "+v"(fr), "+v"(fq));
#pragma unroll
        for (int ai = 0; ai < 2; ++ai)
#pragma unroll
            for (int m = 0; m < 4; ++m) {
                const f32x4 a[2][2] = {{acc[ai][0][m][0], acc[ai][0][m][1]}, {acc[ai][1][m][0], acc[ai][1][m][1]}};
                rowgroup(a, u.pm, u.pn, wr * 64 + fr + ai * 128 + m * 16, wc, fq);
            }
    }
};
template <class Epi>
__device__ __forceinline__ void tail_fixup(const Epi& E, const pg8::StaticOrder& S, const float* pbuf) {
        const int tid = threadIdx.x, wid = __builtin_amdgcn_readfirstlane(tid >> 6), lane = tid & 63, wr = wid >> 2, wc = wid & 3, fr = lane & 15, fq = lane >> 4;
        for (int it = blockIdx.x; it < S.tail * 8; it += gridDim.x) {
            const int j = it >> 3, ai = (it >> 2) & 1, m = it & 3;
            pg8::Unit u; S.map(S.full + j, u);
            f32x4 a[2][2];
#pragma unroll
            for (int bj = 0; bj < 2; ++bj)
#pragma unroll
                for (int n = 0; n < 2; ++n) a[bj][n] = (f32x4){0.f, 0.f, 0.f, 0.f};
            for (int pp0 = 0; pp0 < S.S; pp0 += 4) {
                f32x4 t[4][2][2];
#pragma unroll
                for (int u4 = 0; u4 < 4; ++u4) {
                    const int pp = (pp0 + u4 < S.S) ? pp0 + u4 : pp0;
                    const float* pb = pbuf + (size_t)(j * S.S + pp) * 65536 + (size_t)wid * 8192 + lane * 4;
#pragma unroll
                    for (int bj = 0; bj < 2; ++bj)
#pragma unroll
                        for (int n = 0; n < 2; ++n) t[u4][bj][n] = *(const f32x4*)(pb + (((ai * 2 + bj) * 4 + m) * 2 + n) * 256);
                }
#pragma unroll
                for (int u4 = 0; u4 < 4; ++u4) {
                    const float wgt = (pp0 + u4 < S.S) ? 1.f : 0.f;
#pragma unroll
                    for (int bj = 0; bj < 2; ++bj)
#pragma unroll
                        for (int n = 0; n < 2; ++n) a[bj][n] += wgt * t[u4][bj][n];
                }
            }
            E.rowgroup(a, u.pm, u.pn, wr * 64 + fr + ai * 128 + m * 16, wc, fq);
        }
}
struct EpiInproj {
    const float* sq; const float* lb; bf16_t *QA, *KA, *VA, *GA, *QB, *KB, *VB, *RB; float* LGA; float* ALOW;
    __device__ __forceinline__ void prefetch(const pg8::Unit& u, int wr, int fr, float (&pre)[8]) const {
        const int row0 = u.pm * 256 + wr * 64 + fr;
#pragma unroll
        for (int i = 0; i < 8; ++i) pre[i] = sq[row0 + (i >> 2) * 128 + (i & 3) * 16];
    }
    __device__ __forceinline__ void operator()(const f32x4 (&acc)[2][2][4][2], const pg8::Unit& u, int wr, int wc, int fr, int fq, const float (&pre)[8]) const {
        asm volatile("" : "+v"(fr), "+v"(fq));
        const int row0 = u.pm * 256 + wr * 64 + fr, pn = u.pn;
        const int cl = wc * 32 + 8 * fq;
        const float qs = 0.08838834764831845f;
        float rsv[8];
#pragma unroll
        for (int i = 0; i < 8; ++i) rsv[i] = rsqrtf(pre[i] * (1.0f / D) + EPS);
#pragma unroll
        for (int ai = 0; ai < 2; ++ai)
#pragma unroll
            for (int m = 0; m < 4; ++m) {
                const int r = row0 + ai * 128 + m * 16;
                const float rs = rsv[ai * 4 + m];
#pragma unroll
                for (int bj = 0; bj < 2; ++bj) {
                    f32x4 x0 = acc[ai][bj][m][0] * rs, x1 = acc[ai][bj][m][1] * rs;
                    const int c = pn * 256 + bj * 128 + cl;
                    if (pn < 4) {
#pragma unroll
                        for (int j = 0; j < 4; ++j) { x0[j] = silu_f(x0[j]) * qs; x1[j] = silu_f(x1[j]) * qs; }
                        *(u32x4*)(QA + (size_t)r * 1024 + c) = pack8(x0, x1);
                    } else if (pn < 8) {
                        const int cc = c - 1024;
                        const f32x4 l0 = *(const f32x4*)(lb + cc), l1 = *(const f32x4*)(lb + cc + 4);
                        f32x4 g0, g1;
#pragma unroll
                        for (int j = 0; j < 4; ++j) {
                            const float s0 = sigmoid_f(x0[j]), s1 = sigmoid_f(x1[j]);
                            g0[j] = __logf(l0[j] + (1.f - l0[j]) * s0); g1[j] = __logf(l1[j] + (1.f - l1[j]) * s1);
                        }
                        *(f32x4*)(LGA + (size_t)r * 1024 + cc) = g0; *(f32x4*)(LGA + (size_t)r * 1024 + cc + 4) = g1;
                    } else if (pn < 12) {
                        *(u32x4*)(VA + (size_t)r * 1024 + (c - 2048)) = pack8(x0, x1);
                    } else if (pn < 16) {
#pragma unroll
                        for (int j = 0; j < 4; ++j) { x0[j] = silu_f(x0[j]); x1[j] = silu_f(x1[j]); }
                        *(u32x4*)(GA + (size_t)r * 1024 + (c - 3072)) = pack8(x0, x1);
                    } else if (pn < 18) {
                        x0 *= qs; x1 *= qs;
                        *(u32x4*)(QB + (size_t)r * 512 + (c - 4096)) = pack8(x0, x1);
                    } else if (pn < 20) {
                        *(u32x4*)(KB + (size_t)r * 512 + (c - 4608)) = pack8(x0, x1);
                    } else if (pn < 24) {
                        *(u32x4*)(VB + (size_t)r * 1024 + (c - 5120)) = pack8(x0, x1);
                    } else if (pn < 28) {
#pragma unroll
                        for (int j = 0; j < 4; ++j) { x0[j] = silu_f(x0[j]); x1[j] = silu_f(x1[j]); }
                        *(u32x4*)(RB + (size_t)r * 1024 + (c - 6144)) = pack8(x0, x1);
                    } else {
                        const int cc = c - 7168;
                        if (cc < 16) { *(f32x4*)(ALOW + (size_t)r * 16 + cc) = x0; *(f32x4*)(ALOW + (size_t)r * 16 + cc + 4) = x1; }
                    }
                }
            }
    }
};

constexpr int TT0 = (NFF / 64) * (D / 256), TT1 = TT0 + (D / 64) * (DFF / 256), TT2 = TT1 + (NINP / 64) * (D / 256), TT3 = TT2 + (D / 64) * (D / 256), TT4 = TT3 + (NFF / 64) * (D / 256), TT5 = TT4 + (D / 64) * (DFF / 256);
struct TJob { const float* src; bf16_t* dst; const float* nw; int K, Nsrc, swi, t; };
__device__ __forceinline__ TJob tjob_decode(const Params& p, int t) {
    unsigned char* ws = p.ws; TJob j;
    if (t < TT0)      { j.src = p.in[7];  j.dst = (bf16_t*)(ws + WS_W1I);  j.nw = p.in[6];  j.K = D;   j.Nsrc = NFF; j.swi = 1; j.t = t; }
    else if (t < TT1) { j.src = p.in[8];  j.dst = (bf16_t*)(ws + WS_W1O);  j.nw = nullptr;  j.K = DFF; j.Nsrc = D;   j.swi = 0; j.t = t - TT0; }
    else if (t < TT2) { j.src = p.in[10]; j.dst = (bf16_t*)(ws + WS_WIN);  j.nw = p.in[9];  j.K = D;   j.Nsrc = NIN; j.swi = 0; j.t = t - TT1; }
    else if (t < TT3) { j.src = p.in[15]; j.dst = (bf16_t*)(ws + WS_WOUT); j.nw = nullptr;  j.K = D;   j.Nsrc = D;   j.swi = 0; j.t = t - TT2; }
    else if (t < TT4) { j.src = p.in[17]; j.dst = (bf16_t*)(ws + WS_W2I);  j.nw = p.in[16]; j.K = D;   j.Nsrc = NFF; j.swi = 1; j.t = t - TT3; }
    else              { j.src = p.in[18]; j.dst = (bf16_t*)(ws + WS_W2O);  j.nw = nullptr;  j.K = DFF; j.Nsrc = D;   j.swi = 0; j.t = t - TT4; }
    return j;
}
__device__ __forceinline__ void tjob_load(const TJob& j, f32x4 (&v)[8]) {
    const int tid = threadIdx.x, tk = j.K / 256, n0 = (j.t / tk) * 64, k0 = (j.t % tk) * 256;
    int c0;
    if (j.swi) { const int pn = n0 >> 8, bj = (n0 >> 7) & 1, jj = n0 & 127; c0 = bj * DFF + pn * 128 + jj; } else c0 = n0;
    const int n4 = (tid & 15) * 4, kr = tid >> 4, col = c0 + n4;
#pragma unroll
    for (int i = 0; i < 8; ++i) v[i] = (col < j.Nsrc) ? __builtin_nontemporal_load((const f32x4*)(j.src + (size_t)(k0 + kr + 32 * i) * j.Nsrc + col)) : (f32x4){0.f, 0.f, 0.f, 0.f};
    if (j.nw) {
#pragma unroll
        for (int i = 0; i < 8; ++i) v[i] *= j.nw[k0 + kr + 32 * i];
    }
}
__device__ __forceinline__ void convert_tiles(const Params& p, LAS unsigned char* lds, int tbeg, int tend, int rank, int nranks) {
    LAS float* tile = (LAS float*)lds;
    const int tid = threadIdx.x, n4 = (tid & 15) * 4, kr = tid >> 4, on = tid >> 3, ksb = tid & 7;
    int t = tbeg + rank;
    if (t >= tend) return;
    TJob job = tjob_decode(p, t);
    f32x4 v[8];
    tjob_load(job, v);
    for (;;) {
#pragma unroll
        for (int i = 0; i < 8; ++i) { LAS float* tp = tile + (kr + 32 * i) * 65 + n4; tp[0] = v[i][0]; tp[1] = v[i][1]; tp[2] = v[i][2]; tp[3] = v[i][3]; }
        __syncthreads();
        const int tn = t + nranks; const bool more = tn < tend;
        TJob jn = job;
        if (more) { jn = tjob_decode(p, tn); tjob_load(jn, v); }
        {
            const int tk = job.K / 256, n0 = (job.t / tk) * 64, k0 = (job.t % tk) * 256;
            const bool late = t >= TT1;
#pragma unroll
            for (int jj = 0; jj < 4; ++jj) {
                const int ks = (ksb + 8 * jj) * 8;
                float x[8];
#pragma unroll
                for (int i = 0; i < 8; ++i) x[i] = tile[(ks + i) * 65 + on];
                u32x4 w; w.x = cvt_pk_bf16(x[0], x[1]); w.y = cvt_pk_bf16(x[2], x[3]); w.z = cvt_pk_bf16(x[4], x[5]); w.w = cvt_pk_bf16(x[6], x[7]);
                if (late) __builtin_nontemporal_store(w, (u32x4*)(job.dst + (size_t)(n0 + on) * job.K + k0 + ks));
                else *(u32x4*)(job.dst + (size_t)(n0 + on) * job.K + k0 + ks) = w;
            }
        }
        __syncthreads();
        if (!more) break;
        t = tn; job = jn;
    }
}

__device__ __forceinline__ void prep_phase(const Params& p, LAS unsigned char* lds) {
    unsigned char* ws = p.ws;
    const int tid = threadIdx.x, lane = tid & 63, gw = blockIdx.x * 8 + (tid >> 6), nw = gridDim.x * 8;
    bf16_t* HB = (bf16_t*)(ws + WS_HB); float* HM = (float*)(ws + WS_HMETA); float* SQ = (float*)(ws + WS_SQ);
    for (int r0 = gw; r0 < MROWS; r0 += 4 * nw) {
        f32x4 v[4][8]; const float* src[4];
#pragma unroll
        for (int u = 0; u < 4; ++u) {
            const int r = r0 + u * nw;
            src[u] = r < ROW_S ? p.in[0] + (size_t)r * D : r < ROW_M ? p.in[1] + (size_t)(r - ROW_S) * D : r < ROW_MEND ? p.in[4] + (size_t)(r - ROW_M) * D : nullptr;
#pragma unroll
            for (int i = 0; i < 8; ++i) v[u][i] = src[u] ? __builtin_nontemporal_load((const f32x4*)(src[u] + (i * 64 + lane) * 4)) : (f32x4){0.f, 0.f, 0.f, 0.f};
        }
#pragma unroll
        for (int u = 0; u < 4; ++u) {
            const int r = r0 + u * nw;
            if (r < MROWS) {
                float* hp = HM + (size_t)(r - ROW_M) * D;
                float ss = 0.f;
#pragma unroll
                for (int i = 0; i < 8; ++i) {
                    const int c = (i * 64 + lane) * 4; const f32x4 x = v[u][i];
                    if (r >= ROW_M) *(f32x4*)(hp + c) = x;
                    u32x2 w; w.x = cvt_pk_bf16(x[0], x[1]); w.y = cvt_pk_bf16(x[2], x[3]);
                    *(u32x2*)(HB + (size_t)r * D + c) = w;
                    ss += (x[0] * x[0] + x[1] * x[1]) + (x[2] * x[2] + x[3] * x[3]);
                }
#pragma unroll
                for (int o = 32; o >= 1; o >>= 1) ss += __shfl_xor(ss, o);
                if (lane == 0) SQ[r] = ss;
            }
        }
    }
    { const int gt = blockIdx.x * NTHREADS + tid, ng = gridDim.x * NTHREADS;
      float* LB = (float*)(ws + WS_LB);
      for (int i = gt; i < 3 * MROWS; i += ng) SQ[MROWS + i] = 0.f;
      for (int i = gt; i < 1024; i += ng) { const float l0 = p.in[5][i], l1 = p.in[5][1024 + i]; LB[i] = 1.f / (1.f + expf(l1 - l0)); } }
    convert_tiles(p, lds, 0, TT0, blockIdx.x, gridDim.x);
}

constexpr int SLOT_KD = 16384, SLOT_AM = 32768, SLOT_EB = 40960, SLOT_BYTES = 41472;
constexpr int IMG_KD = 17408, IMG_AM = 35840, IMG_EB = 45056, IMG_BYTES = 45568, IMG_BUF = 49152;

#define LDS_BARRIER() do { asm volatile("s_waitcnt lgkmcnt(0)" ::: "memory"); __builtin_amdgcn_s_barrier(); asm volatile("" ::: "memory"); } while (0)
struct PreItem { int row0, ntok, h; };
__device__ __forceinline__ PreItem pre_decode(int i) { PreItem it; if (i < 1536) { const int bc = i / 12; it.h = i - bc * 12; it.row0 = bc * 64; it.ntok = 64; } else { it.h = i - 1536; it.row0 = ROW_M; it.ntok = 16; } return it; }

struct PreRaw { float lg[16]; bf16_t q[16], k[16]; f32x2 al; float wup[16]; float bal; };
__device__ __forceinline__ void pre_load(const Params& p, const PreItem it, int tid, PreRaw& r) {
    unsigned char* ws = p.ws;
    const bool gla = it.h >= 8; const int head = gla ? it.h - 8 : it.h, ch0 = head * 128, ch = tid & 127, tg = tid >> 7;
    const bf16_t* Q = (const bf16_t*)(ws + (gla ? WS_QB : WS_QA)); const bf16_t* Kp = (const bf16_t*)(ws + (gla ? WS_KB : WS_KA));
    const float* LGA = (const float*)(ws + WS_LGA); const float* ALOW = (const float*)(ws + WS_ALOW);
    const int ldq = gla ? 512 : 1024;
    r.al = (f32x2){0.f, 0.f}; r.bal = 0.f;
    if (gla) {
        const int idx = tid * 2, t = idx >> 4;
        if (t < it.ntok) r.al = *(const f32x2*)(ALOW + (size_t)(it.row0 + t) * 16 + (idx & 15));
#pragma unroll
        for (int j = 0; j < 16; ++j) r.wup[j] = p.in[11][j * 512 + ch0 + ch];
        r.bal = p.in[12][ch0 + ch];
    } else {
#pragma unroll
        for (int j = 0; j < 16; ++j) r.wup[j] = 0.f;
    }
#pragma unroll
    for (int i = 0; i < 16; ++i) {
        const int t = tg * 16 + i; const bool v = t < it.ntok; const size_t o = (size_t)(it.row0 + t) * ldq + ch0 + ch;
        r.lg[i] = (!gla && v) ? __builtin_nontemporal_load(LGA + (size_t)(it.row0 + t) * 1024 + ch0 + ch) : 0.f;
        r.q[i] = v ? __builtin_nontemporal_load(Q + o) : (bf16_t)0; r.k[i] = (gla && v) ? __builtin_nontemporal_load(Kp + o) : (bf16_t)0;
    }
}

template <int DV> struct SRaw { f32x4 S[DV / 16]; float lg[8]; bf16_t q[8], k[8]; float al; float wup[16]; float bal; bf16_t v[DV / 64]; };
template <int DV, bool WITH_S, bool WITH_RAW>
__device__ __forceinline__ void sample_load(const Params& p, int seq, int head, SRaw<DV>& r) {
    constexpr bool GLA = (DV == 256); constexpr int NH = GLA ? 4 : 8, R = DV / 16, VPL = DV / 64;
    unsigned char* ws = p.ws;
    const int tid = threadIdx.x, w = __builtin_amdgcn_readfirstlane(tid >> 6), lane = tid & 63;
    const int row0 = ROW_S + seq * 8, ch0 = head * 128;
    const float* s0 = (GLA ? p.in[3] : p.in[2]) + ((size_t)(seq * NH + head) * 128) * DV;
    const int v4 = GLA ? lane * 4 : (lane & 31) * 4;
    if (WITH_S) {
#pragma unroll
        for (int i = 0; i < R; ++i) { const int k = GLA ? 16 * w + i : 16 * w + 2 * i + (lane >> 5); r.S[i] = __builtin_nontemporal_load((const f32x4*)(s0 + (size_t)k * DV + v4)); }
    }
    if (!WITH_RAW) return;
    r.al = 0.f; r.bal = 0.f;
    if (tid < 128) {
        const int ch = tid;
        const bf16_t* Q = (const bf16_t*)(ws + (GLA ? WS_QB : WS_QA)); const bf16_t* Kp = (const bf16_t*)(ws + (GLA ? WS_KB : WS_KA));
        const int ldq = GLA ? 512 : 1024;
        if (GLA) {
            r.al = ((const float*)(ws + WS_ALOW))[(size_t)row0 * 16 + tid];
#pragma unroll
            for (int j = 0; j < 16; ++j) r.wup[j] = p.in[11][j * 512 + ch0 + ch];
            r.bal = p.in[12][ch0 + ch];
        }
#pragma unroll
        for (int t = 0; t < 8; ++t) {
            r.lg[t] = GLA ? 0.f : __builtin_nontemporal_load((const float*)(ws + WS_LGA) + (size_t)(row0 + t) * 1024 + ch0 + ch);
            r.q[t] = __builtin_nontemporal_load(Q + (size_t)(row0 + t) * ldq + ch0 + ch); r.k[t] = GLA ? __builtin_nontemporal_load(Kp + (size_t)(row0 + t) * ldq + ch0 + ch) : (bf16_t)0;
        }
    }
    {
        const bf16_t* V = (const bf16_t*)(ws + (GLA ? WS_VB : WS_VA));
        const int t = tid >> 6, vv = (tid & 63) * VPL;
#pragma unroll
        for (int i = 0; i < VPL; ++i) r.v[i] = V[(size_t)(row0 + t) * 1024 + head * DV + vv + i];
    }
}
template <int DV>
__device__ __forceinline__ void sample_compute(const Params& p, LAS unsigned char* lds, int seq, int head, const SRaw<DV>& r) {
    constexpr bool GLA = (DV == 256); constexpr int NH = GLA ? 4 : 8, R = DV / 16, VPL = DV / 64;
    unsigned char* ws = p.ws;
    LAS float* QS = (LAS float*)(lds);
    LAS float* KS = (LAS float*)(lds + 4096);
    LAS float* KN = (LAS float*)(lds + 8192);
    LAS float* Q2 = (LAS float*)(lds + 12288);
    LAS float* ES = (LAS float*)(lds + 16384);
    LAS float* AS = (LAS float*)(lds + 16896);
    LAS float* VS = (LAS float*)(lds + 17152);
    LAS float* ORED = (LAS float*)(lds + 25344);
    LAS float* AL = (LAS float*)(lds + 90880);
    const int tid = threadIdx.x, w = __builtin_amdgcn_readfirstlane(tid >> 6), lane = tid & 63;
    const int row0 = ROW_S + seq * 8;
    const int hidx = GLA ? 8 + head : head, ocol = GLA ? 1024 + head * 256 : head * 128;
    float* so = p.out + (GLA ? OUT_SBS : OUT_SAS) + ((size_t)(seq * NH + head) * 128) * DV;
    const int v4 = GLA ? lane * 4 : (lane & 31) * 4;
    if (GLA) { if (tid < 128) AL[tid] = r.al; LDS_BARRIER(); }
    if (tid < 128) {
        const int ch = tid;
        float B[8];
        if (GLA) {
#pragma unroll
            for (int t = 0; t < 8; ++t) {
                float x = r.bal;
#pragma unroll
                for (int j = 0; j < 16; ++j) x += AL[t * 16 + j] * r.wup[j];
                B[t] = (fminf(x, 0.f) - __logf(1.f + __expf(-fabsf(x)))) * (1.0f / 16.0f);
            }
        } else {
#pragma unroll
            for (int t = 0; t < 8; ++t) B[t] = r.lg[t];
        }
        float kk[8];
#pragma unroll
        for (int t = 0; t < 8; ++t) kk[t] = GLA ? bf2f(r.k[t]) : 1.f - __expf(B[t]);
#pragma unroll
        for (int t = 1; t < 8; ++t) B[t] += B[t - 1];
        const float bl = B[7];
#pragma unroll
        for (int t = 0; t < 8; ++t) {
            const float q = bf2f(r.q[t]), k = kk[t];
            const float qb = q * __expf(B[t]);
            QS[ch * 8 + t] = qb; Q2[t * 128 + ch] = qb; KS[ch * 8 + t] = k * __expf(bl - B[t]); KN[t * 128 + ch] = k * __expf(fminf(-B[t], 80.f));
        }
        ES[ch] = __expf(bl);
    }
    {
        const int t = tid >> 6, vv = (tid & 63) * VPL;
#pragma unroll
        for (int i = 0; i < VPL; ++i) VS[t * DV + vv + i] = bf2f(r.v[i]);
    }
    LDS_BARRIER();
    {
        const int pair = tid >> 3, kp = tid & 7, t = pair >> 3, s = pair & 7;
        float a = 0.f;
#pragma unroll
        for (int i = 0; i < 16; ++i) a += Q2[t * 128 + kp * 16 + i] * KN[s * 128 + kp * 16 + i];
        a += __shfl_xor(a, 1); a += __shfl_xor(a, 2); a += __shfl_xor(a, 4);
        if (kp == 0) AS[pair] = (s <= t) ? a : 0.f;
    }
    {
        f32x4 vreg[8], oacc[8];
#pragma unroll
        for (int t = 0; t < 8; ++t) { vreg[t] = *(const LAS f32x4*)(VS + t * DV + v4); oacc[t] = (f32x4){0.f, 0.f, 0.f, 0.f}; }
#pragma unroll
        for (int i = 0; i < R; ++i) {
            const int k = GLA ? 16 * w + i : 16 * w + 2 * i + (lane >> 5);
            const f32x4 q0 = *(const LAS f32x4*)(QS + k * 8), q1 = *(const LAS f32x4*)(QS + k * 8 + 4);
            const f32x4 k0 = *(const LAS f32x4*)(KS + k * 8), k1 = *(const LAS f32x4*)(KS + k * 8 + 4);
            const float e = ES[k];
            const f32x4 sv = r.S[i];
            f32x4 sn = e * sv;
#pragma unroll
            for (int t = 0; t < 4; ++t) { oacc[t] += q0[t] * sv; oacc[t + 4] += q1[t] * sv; sn += k0[t] * vreg[t]; sn += k1[t] * vreg[t + 4]; }
            __builtin_nontemporal_store(sn, (f32x4*)(so + (size_t)k * DV + v4));
        }
        if (!GLA) {
#pragma unroll
            for (int t = 0; t < 8; ++t)
#pragma unroll
                for (int j = 0; j < 4; ++j) oacc[t][j] += __shfl_xor(oacc[t][j], 32);
        }
        if (GLA || lane < 32) {
#pragma unroll
            for (int t = 0; t < 8; ++t) *(LAS f32x4*)(ORED + (w * 8 + t) * DV + v4) = oacc[t];
        }
    }
    LDS_BARRIER();
    {
        const int t = w, vv = lane * VPL;
        float o[VPL]; float ss = 0.f;
#pragma unroll
        for (int i = 0; i < VPL; ++i) {
            float x = 0.f;
#pragma unroll
            for (int ww = 0; ww < 8; ++ww) x += ORED[(ww * 8 + t) * DV + vv + i];
#pragma unroll
            for (int s2 = 0; s2 < 8; ++s2) x += AS[t * 8 + s2] * VS[s2 * DV + vv + i];
            o[i] = x; ss += x * x;
        }
#pragma unroll
        for (int off = 32; off >= 1; off >>= 1) ss += __shfl_xor(ss, off);
        bf16_t* OS = (bf16_t*)(ws + WS_OS) + (size_t)(row0 + t) * D + ocol + vv;
        if (VPL == 2) *(unsigned*)OS = cvt_pk_bf16(o[0], o[1]);
        else { u32x2 pk; pk.x = cvt_pk_bf16(o[0], o[1]); pk.y = cvt_pk_bf16(o[VPL - 2], o[VPL - 1]); *(u32x2*)OS = pk; }
        if (lane < 4) { const f32x4 z = (f32x4){lane == 0 ? ss : 0.f, 0.f, 0.f, 0.f}; *(f32x4*)((float*)(ws + WS_SSP) + ((size_t)(row0 + t) * 12 + hidx) * 16 + lane * 4) = z; }
    }
    LDS_BARRIER();
}
template <int DV>
__device__ __forceinline__ void sample_loop(const Params& p, LAS unsigned char* lds) {
    constexpr int NHD = (DV == 256) ? 4 : 8, TOTAL = 128 * NHD;
    const int G = gridDim.x;
    constexpr bool PS = (DV == 128);
    int it = blockIdx.x;
    if (it >= TOTAL) return;
    SRaw<DV> nxt;
    sample_load<DV, PS, true>(p, it / NHD, it % NHD, nxt);
    for (; it < TOTAL; it += G) {
        SRaw<DV> cur = nxt;
        if (!PS) sample_load<DV, true, false>(p, it / NHD, it % NHD, cur);
        if (it + G < TOTAL) sample_load<DV, PS, true>(p, (it + G) / NHD, (it + G) % NHD, nxt);
        sample_compute<DV>(p, lds, it / NHD, it % NHD, cur);
    }
}

__device__ __forceinline__ int pre_item_of(int bx, int j, int G) {
    if (G != 256) { const int i = bx + j * G; return i < 1548 ? i : -1; }
    if (j < 6) {
        const int x = bx & 7, l = (bx >> 3) + 32 * j, pair = l >> 5, chunk = l & 31;
        const bool gla = pair >= 4;
        const int grp = gla ? 2 * x + (pair - 4) : 4 * x + pair;
        const int b = gla ? grp >> 2 : grp >> 3, hidx = gla ? 8 + (grp & 3) : grp & 7;
        return (b * 32 + chunk) * 12 + hidx;
    }
    return (j == 6 && bx < 12) ? 1536 + bx : -1;
}
__device__ __forceinline__ void scan_pre_phase(const Params& p, LAS unsigned char* lds) {
    unsigned char* ws = p.ws;
    LAS bf16_t* Qt = (LAS bf16_t*)(lds);
    LAS bf16_t* Kt = (LAS bf16_t*)(lds + 17408);
    LAS float* Bc = (LAS float*)(lds + 34816);
    LAS float* AL = (LAS float*)(lds + 36864);
    const int tid = threadIdx.x, w = __builtin_amdgcn_readfirstlane(tid >> 6), lane = tid & 63, fr = lane & 15, fq = lane >> 4;
    const int ch = tid & 127, tg = tid >> 7, ti = w >> 1, sjb = (w & 1) * 2;
    PreRaw raw;
    const int G = gridDim.x, bx = blockIdx.x;
    int jj = 0, i = pre_item_of(bx, 0, G);
    if (i >= 0) pre_load(p, pre_decode(i), tid, raw);
    for (; i >= 0; ) {
        const int inext = pre_item_of(bx, ++jj, G);
        const PreItem it = pre_decode(i);
        const bool gla = it.h >= 8;
        unsigned char* slot = ws + WS_SLOT + (size_t)i * SLOT_BYTES;
        float c[16];
        if (gla) {
            *(LAS f32x2*)(AL + tid * 2) = raw.al;
            LDS_BARRIER();
#pragma unroll
            for (int j = 0; j < 16; ++j) {
                const int t = tg * 16 + j;
                float x = raw.bal;
#pragma unroll
                for (int jj = 0; jj < 16; ++jj) x += AL[t * 16 + jj] * raw.wup[jj];
                const float ls = fminf(x, 0.f) - __logf(1.f + __expf(-fabsf(x)));
                c[j] = (t < it.ntok) ? ls * (1.0f / 16.0f) : 0.f;
            }
        } else {
#pragma unroll
            for (int j = 0; j < 16; ++j) c[j] = raw.lg[j];
        }
        float kq[16];
#pragma unroll
        for (int j = 0; j < 16; ++j) kq[j] = gla ? bf2f(raw.k[j]) : 1.f - __expf(c[j]);
#pragma unroll
        for (int j = 1; j < 16; ++j) c[j] += c[j - 1];
        Bc[tg * 128 + ch] = c[15];
        LDS_BARRIER();
        const float t0 = Bc[ch], t1 = Bc[128 + ch], t2 = Bc[256 + ch], t3 = Bc[384 + ch];
        const float off = tg == 0 ? 0.f : tg == 1 ? t0 : tg == 2 ? t0 + t1 : t0 + t1 + t2;
        const float rr = t0 + t1, bl = (t0 + t1) + (t2 + t3);
        const float er = __expf(rr), el = __expf(bl - rr);
        if (tg == 0) ((float*)(slot + SLOT_EB))[ch] = __expf(bl);
        {
            float kd[16];
            bf16_t* qbg = (bf16_t*)slot;
#pragma unroll
            for (int j = 0; j < 16; ++j) {
                const int t = tg * 16 + j;
                const float qv = bf2f(raw.q[j]), kv = kq[j];
                const float B = c[j] + off;
                const float eA = __expf(fminf(B - rr, 80.f)), eB = __expf(fminf(rr - B, 80.f));
                const float qt = qv * eA, kt = kv * eB;
                Qt[t * 136 + ch] = f2bf(qt); Kt[t * 136 + ch] = f2bf(kt);
                qbg[t * 128 + ch] = f2bf(qt * er);
                kd[j] = kt * el;
            }
            u32x4 w0, w1;
            w0.x = cvt_pk_bf16(kd[0], kd[1]); w0.y = cvt_pk_bf16(kd[2], kd[3]); w0.z = cvt_pk_bf16(kd[4], kd[5]); w0.w = cvt_pk_bf16(kd[6], kd[7]);
            w1.x = cvt_pk_bf16(kd[8], kd[9]); w1.y = cvt_pk_bf16(kd[10], kd[11]); w1.z = cvt_pk_bf16(kd[12], kd[13]); w1.w = cvt_pk_bf16(kd[14], kd[15]);
            bf16_t* kdg = (bf16_t*)(slot + SLOT_KD) + ch * 64 + tg * 16;
            *(u32x4*)kdg = w0; *(u32x4*)(kdg + 8) = w1;
        }
        if (inext >= 0) pre_load(p, pre_decode(inext), tid, raw);
        LDS_BARRIER();
        bf16_t* amg = (bf16_t*)(slot + SLOT_AM);
#pragma unroll
        for (int q = 0; q < 2; ++q) {
            const int sj = sjb + q;
            f32x4 aacc = (f32x4){0.f, 0.f, 0.f, 0.f};
#pragma unroll
            for (int kk = 0; kk < 4; ++kk) {
                const bf16x8 a = *(const LAS bf16x8*)(Qt + (16 * ti + fr) * 136 + 32 * kk + 8 * fq);
                const bf16x8 b = *(const LAS bf16x8*)(Kt + (16 * sj + fr) * 136 + 32 * kk + 8 * fq);
                aacc = __builtin_amdgcn_mfma_f32_16x16x32_bf16(a, b, aacc, 0, 0, 0);
            }
#pragma unroll
            for (int j = 0; j < 4; ++j) { const int t = 16 * ti + 4 * fq + j, s = 16 * sj + fr; amg[t * 64 + s] = f2bf(s <= t ? aacc[j] : 0.f); }
        }
        LDS_BARRIER();
        i = inext;
    }
}
__device__ __forceinline__ void scan_sample_phase(const Params& p, LAS unsigned char* lds) {
    sample_loop<128>(p, lds);
    sample_loop<256>(p, lds);
}

__device__ __forceinline__ void scan_seq_phase(const Params& p, LAS unsigned char* lds) {
    unsigned char* ws = p.ws;
    LAS bf16_t* Vt = (LAS bf16_t*)(lds + 2 * IMG_BUF);
    LAS bf16_t* St = (LAS bf16_t*)(lds + 2 * IMG_BUF + 4608);
    const int tid = threadIdx.x, w = __builtin_amdgcn_readfirstlane(tid >> 6), lane = tid & 63, fr = lane & 15, fq = lane >> 4;
    const int ti = w >> 1, vj = w & 1, vi = w >> 2, kj0 = (w & 3) * 2;
    unsigned soff[6];
#pragma unroll
    for (int i = 0; i < 6; ++i) {
        const int P = (tid + 512 * i) * 16; unsigned o = 0;
        if (P < IMG_KD) { const int row = P / 272, cb = P % 272; o = cb < 256 ? row * 256 + cb : 0; }
        else if (P < IMG_AM) { const int Pp = P - IMG_KD, row = Pp / 144, cb = Pp % 144; o = cb < 128 ? SLOT_KD + row * 128 + cb : 0; }
        else if (P < IMG_EB) { const int Pp = P - IMG_AM, row = Pp / 144, cb = Pp % 144; o = cb < 128 ? SLOT_AM + row * 128 + cb : 0; }
        else if (P < IMG_BYTES) o = SLOT_EB + (P - IMG_EB);
        soff[i] = o;
    }
    bf16_t* OS = (bf16_t*)(ws + WS_OS); float* SSP = (float*)(ws + WS_SSP);
#define SEQ_DMA(SLOTI, BUF) do { const unsigned char* sb_ = ws + WS_SLOT + (size_t)(SLOTI) * SLOT_BYTES; _Pragma("unroll") for (int i_ = 0; i_ < 6; ++i_) \
        __builtin_amdgcn_global_load_lds((const unsigned*)(sb_ + soff[i_]), (LAS unsigned*)((BUF) + w * 1024 + i_ * 8192), 16, 0, 0); } while (0)
    for (int item = blockIdx.x; item < 256; item += gridDim.x) {
        const int xcd = item & 7, ii = item >> 3;
        const bool gla = ii >= 16;
        const int grp = gla ? xcd * 2 + ((ii - 16) >> 3) : xcd * 4 + (ii >> 2);
        const int vs = gla ? (ii - 16) & 7 : ii & 3;
        const int b = gla ? grp >> 2 : grp >> 3, head = gla ? grp & 3 : grp & 7;
        const int DV = gla ? 256 : 128, NH = gla ? 4 : 8;
        const int vcol = head * DV + vs * 32, ocol = (gla ? 1024 : 0) + vcol, hidx = gla ? 8 + head : head;
        const bf16_t* V = (const bf16_t*)(ws + (gla ? WS_VB : WS_VA));
        f32x4 Sacc[2];
        Sacc[0] = (f32x4){0.f, 0.f, 0.f, 0.f}; Sacc[1] = Sacc[0];
#pragma unroll
        for (int q = 0; q < 2; ++q)
#pragma unroll
            for (int j = 0; j < 4; ++j) St[(16 * vi + 4 * fq + j) * 136 + 16 * (kj0 + q) + fr] = (bf16_t)0;
        const int sv = tid >> 3, v4 = (tid & 7) * 4;
        u32x2 vr;
        SEQ_DMA(1536 + hidx, lds);
        vr = (sv < 16) ? *(const u32x2*)(V + (size_t)(ROW_M + sv) * 1024 + vcol + v4) : (u32x2){0u, 0u};
        f32x4 oprev = (f32x4){0.f, 0.f, 0.f, 0.f};
        for (int step = 0; step < 33; ++step) {
            LAS unsigned char* cur = lds + (step & 1) * IMG_BUF;
            Vt[(v4 + 0) * 72 + sv] = (bf16_t)(vr.x & 0xffffu); Vt[(v4 + 1) * 72 + sv] = (bf16_t)(vr.x >> 16);
            Vt[(v4 + 2) * 72 + sv] = (bf16_t)(vr.y & 0xffffu); Vt[(v4 + 3) * 72 + sv] = (bf16_t)(vr.y >> 16);
            asm volatile("s_waitcnt vmcnt(0) lgkmcnt(0)" ::: "memory");
            __builtin_amdgcn_s_barrier(); asm volatile("" ::: "memory");
            if (step + 1 < 33) {
                SEQ_DMA((b * 32 + step) * 12 + hidx, lds + ((step + 1) & 1) * IMG_BUF);
                vr = __builtin_nontemporal_load((const u32x2*)(V + (size_t)(b * 2048 + step * 64 + sv) * 1024 + vcol + v4));
            }
            asm volatile("" ::: "memory");
            if (step > 1) {
                const int row0 = b * 2048 + (step - 2) * 64;
                float s2[4];
#pragma unroll
                for (int j = 0; j < 4; ++j) s2[j] = row16_sum(oprev[j] * oprev[j]);
#pragma unroll
                for (int j = 0; j < 4; ++j) OS[(size_t)(row0 + 16 * ti + 4 * fq + j) * D + ocol + 16 * vj + fr] = f2bf(oprev[j]);
#pragma unroll
                for (int j = 0; j < 4; ++j) SSP[((size_t)(row0 + 16 * ti + 4 * fq + j) * 12 + hidx) * 16 + vs * 2 + vj] = s2[j];
            }
            asm volatile("" ::: "memory");
            const LAS bf16_t* Qb = (const LAS bf16_t*)cur; const LAS bf16_t* Kd = (const LAS bf16_t*)(cur + IMG_KD);
            const LAS bf16_t* Am = (const LAS bf16_t*)(cur + IMG_AM); const LAS float* EB = (const LAS float*)(cur + IMG_EB);
            f32x4 oacc = (f32x4){0.f, 0.f, 0.f, 0.f};
#pragma unroll
            for (int kk = 0; kk < 4; ++kk) {
                const bf16x8 a = *(const LAS bf16x8*)(Qb + (16 * ti + fr) * 136 + 32 * kk + 8 * fq);
                const bf16x8 bb = *(const LAS bf16x8*)(St + (16 * vj + fr) * 136 + 32 * kk + 8 * fq);
                oacc = __builtin_amdgcn_mfma_f32_16x16x32_bf16(a, bb, oacc, 0, 0, 0);
            }
#pragma unroll
            for (int s2 = 0; s2 < 2; ++s2) {
                const bf16x8 a = *(const LAS bf16x8*)(Am + (16 * ti + fr) * 72 + 32 * s2 + 8 * fq);
                const bf16x8 bb = *(const LAS bf16x8*)(Vt + (16 * vj + fr) * 72 + 32 * s2 + 8 * fq);
                oacc = __builtin_amdgcn_mfma_f32_16x16x32_bf16(a, bb, oacc, 0, 0, 0);
            }
#pragma unroll
            for (int q = 0; q < 2; ++q) {
                const int kj = kj0 + q;
                const float e = EB[16 * kj + fr];
                Sacc[q] *= e;
#pragma unroll
                for (int s2 = 0; s2 < 2; ++s2) {
                    const bf16x8 a = *(const LAS bf16x8*)(Vt + (16 * vi + fr) * 72 + 32 * s2 + 8 * fq);
                    const bf16x8 bb = *(const LAS bf16x8*)(Kd + (16 * kj + fr) * 72 + 32 * s2 + 8 * fq);
                    Sacc[q] = __builtin_amdgcn_mfma_f32_16x16x32_bf16(a, bb, Sacc[q], 0, 0, 0);
                }
            }
            oprev = oacc;
            asm volatile("s_waitcnt lgkmcnt(0)" ::: "memory"); __builtin_amdgcn_s_barrier(); asm volatile("" ::: "memory");
#pragma unroll
            for (int q = 0; q < 2; ++q)
#pragma unroll
                for (int j = 0; j < 4; ++j) St[(16 * vi + 4 * fq + j) * 136 + 16 * (kj0 + q) + fr] = f2bf(Sacc[q][j]);
        }
        {
            const int row0 = b * 2048 + 31 * 64;
            float s2[4];
#pragma unroll
            for (int j = 0; j < 4; ++j) s2[j] = row16_sum(oprev[j] * oprev[j]);
#pragma unroll
            for (int j = 0; j < 4; ++j) OS[(size_t)(row0 + 16 * ti + 4 * fq + j) * D + ocol + 16 * vj + fr] = f2bf(oprev[j]);
#pragma unroll
            for (int j = 0; j < 4; ++j) SSP[((size_t)(row0 + 16 * ti + 4 * fq + j) * 12 + hidx) * 16 + vs * 2 + vj] = s2[j];
        }
        {
            float* so = p.out + (gla ? OUT_SBP : OUT_SAP) + ((size_t)(b * NH + head) * 128) * DV + vs * 32 + 16 * vi + 4 * fq;
#pragma unroll
            for (int q = 0; q < 2; ++q) *(f32x4*)(so + (size_t)(16 * (kj0 + q) + fr) * DV) = Sacc[q];
        }
        __syncthreads();
    }
#undef SEQ_DMA
}

__device__ __forceinline__ void norm_gate_phase(const Params& p) {
    unsigned char* ws = p.ws;
    const bf16_t* OS = (const bf16_t*)(ws + WS_OS); const float* SSP = (const float*)(ws + WS_SSP);
    const bf16_t* GA = (const bf16_t*)(ws + WS_GA); const bf16_t* RB = (const bf16_t*)(ws + WS_RB);
    bf16_t* OB = (bf16_t*)(ws + WS_QA);
    const int gt = blockIdx.x * NTHREADS + threadIdx.x, ng = gridDim.x * NTHREADS;
    constexpr int NIT = ROW_M * 256;
    for (int i0 = gt; i0 < NIT; i0 += 8 * ng) {
        u32x4 ov[8], gv[8]; float ssv[8];
#pragma unroll
        for (int u = 0; u < 8; ++u) {
            const int i = i0 + u * ng;
            if (i < NIT) {
                const int r = i >> 8, c = (i & 255) * 8; const bool gla = c >= 1024;
                ov[u] = __builtin_nontemporal_load((const u32x4*)(OS + (size_t)r * D + c));
                gv[u] = gla ? __builtin_nontemporal_load((const u32x4*)(RB + (size_t)r * 1024 + (c - 1024))) : __builtin_nontemporal_load((const u32x4*)(GA + (size_t)r * 1024 + c));
                {   const float* sp = SSP + ((size_t)r * 12 + (gla ? 8 + ((c - 1024) >> 8) : c >> 7)) * 16;
                    const f32x4 q0 = *(const f32x4*)sp, q1 = *(const f32x4*)(sp + 4);
                    float t = (q0[0] + q0[1]) + (q0[2] + q0[3]) + (q1[0] + q1[1]) + (q1[2] + q1[3]);
                    if (gla) { const f32x4 q2 = *(const f32x4*)(sp + 8), q3 = *(const f32x4*)(sp + 12); t += (q2[0] + q2[1]) + (q2[2] + q2[3]) + (q3[0] + q3[1]) + (q3[2] + q3[3]); }
                    ssv[u] = t; }
            }
        }
#pragma unroll
        for (int u = 0; u < 8; ++u) {
            const int i = i0 + u * ng;
            if (i < NIT) {
                const int r = i >> 8, c = (i & 255) * 8; const bool gla = c >= 1024;
                const float sc = rsqrtf(ssv[u] * (gla ? 1.0f / 256.0f : 1.0f / 128.0f) + EPS);
                const float* gn = gla ? p.in[14] + (c - 1024) : p.in[13] + c;
                const f32x4 n0 = *(const f32x4*)(gn), n1 = *(const f32x4*)(gn + 4);
                const u32x4 gt4 = gv[u], o4 = ov[u];
                f32x4 g0, g1, o0, o1;
                g0[0] = __uint_as_float(gt4.x << 16); g0[1] = __uint_as_float(gt4.x & 0xffff0000u); g0[2] = __uint_as_float(gt4.y << 16); g0[3] = __uint_as_float(gt4.y & 0xffff0000u);
                g1[0] = __uint_as_float(gt4.z << 16); g1[1] = __uint_as_float(gt4.z & 0xffff0000u); g1[2] = __uint_as_float(gt4.w << 16); g1[3] = __uint_as_float(gt4.w & 0xffff0000u);
                o0[0] = __uint_as_float(o4.x << 16); o0[1] = __uint_as_float(o4.x & 0xffff0000u); o0[2] = __uint_as_float(o4.y << 16); o0[3] = __uint_as_float(o4.y & 0xffff0000u);
                o1[0] = __uint_as_float(o4.z << 16); o1[1] = __uint_as_float(o4.z & 0xffff0000u); o1[2] = __uint_as_float(o4.w << 16); o1[3] = __uint_as_float(o4.w & 0xffff0000u);
                *(u32x4*)(OB + (size_t)r * D + c) = pack8(o0 * sc * n0 * g0, o1 * sc * n1 * g1);
            }
        }
    }
}

__device__ __forceinline__ void final_norm_phase(const Params& p) {
    const float* SQ3 = (const float*)(p.ws + WS_SQ) + 3 * MROWS;
    const float* fn = p.in[19];
    const int gt = blockIdx.x * NTHREADS + threadIdx.x, ng = gridDim.x * NTHREADS;
    constexpr int NIT = ROW_M * 512;
    for (int i0 = gt; i0 < NIT; i0 += 8 * ng) {
        f32x4 h[8]; float sq[8];
#pragma unroll
        for (int u = 0; u < 8; ++u) { const int i = i0 + u * ng; if (i < NIT) { h[u] = __builtin_nontemporal_load((const f32x4*)(p.out + (size_t)i * 4)); sq[u] = SQ3[i >> 9]; } }
#pragma unroll
        for (int u = 0; u < 8; ++u) { const int i = i0 + u * ng; if (i < NIT) { const f32x4 f = *(const f32x4*)(fn + (i & 511) * 4); __builtin_nontemporal_store(h[u] * rsqrtf(sq[u] * (1.0f / D) + EPS) * f, (f32x4*)(p.out + (size_t)i * 4)); } }
    }
}

#define XB_TMO      128
#define XB_XCNT(j)  (256  + 64 * (j))
#define XB_XSUB(j)  (1280 + 64 * (j))
#define XB_XGEN(j)  (2304 + 64 * (j))
#define XB_TOP      3328
#define XB_TOPGEN   3392
#define XCD_BAR_WORDS 3456
#define XB_SPIN_CAP (1u << 20)
__device__ __forceinline__ unsigned xb_ld(unsigned* p)              { return __hip_atomic_load(p, __ATOMIC_RELAXED, __HIP_MEMORY_SCOPE_AGENT); }
__device__ __forceinline__ unsigned xb_add(unsigned* p, unsigned v) { return __hip_atomic_fetch_add(p, v, __ATOMIC_RELAXED, __HIP_MEMORY_SCOPE_AGENT); }
__device__ __forceinline__ unsigned xb_xcc_id() { return (unsigned)__builtin_amdgcn_s_getreg((3 << 11) | 20) & 0xFu; }
#define XB_SPIN(cond, bar) do { unsigned _sp = 0; while (cond) { __builtin_amdgcn_s_sleep(6); \
    if ((++_sp & 255u) == 0u) { if (xb_ld(&(bar)[XB_TMO])) break; if (_sp > XB_SPIN_CAP) { atomicAdd(&(bar)[XB_TMO], 1u); break; } } } } while (0)
struct XcdBarrier { unsigned* bar; unsigned x; volatile LAS unsigned* st; };
__device__ __forceinline__ XcdBarrier xcd_barrier_post(unsigned* bar, volatile LAS unsigned* st) {
    XcdBarrier b; b.bar = bar; b.x = xb_xcc_id(); b.st = st;
    if (threadIdx.x == 0) (void)xb_add(&bar[XB_XCNT(b.x)], 1u);
    return b;
}
__device__ __forceinline__ void xcd_barrier_complete(unsigned* bar, unsigned x, unsigned& nloc, unsigned& nx) {
    const unsigned G = gridDim.x * gridDim.y * gridDim.z;
    unsigned sum, cnt, mine, sp = 0u;
    for (;;) {
        sum = 0u; cnt = 0u; mine = 0u;
#pragma unroll
        for (unsigned j = 0; j < 16; ++j) { const unsigned c = xb_ld(&bar[XB_XCNT(j)]); sum += c; cnt += (c > 0u) ? 1u : 0u; mine = (j == x) ? c : mine; }
        if (sum == G) break;
        __builtin_amdgcn_s_sleep(1);
        if ((++sp & 255u) == 0u) { if (xb_ld(&bar[XB_TMO])) break; if (sp > XB_SPIN_CAP) { atomicAdd(&bar[XB_TMO], 1u); break; } }
    }
    nloc = mine > 0u ? mine : 1u; nx = cnt > 0u ? cnt : 1u;
}
__device__ __forceinline__ void xcd_barrier(const XcdBarrier& b) {
    asm volatile("s_waitcnt vmcnt(0)" ::: "memory");
    __syncthreads();
    if (threadIdx.x == 0) {
        unsigned* bar = b.bar;
        __builtin_amdgcn_s_waitcnt(0);
        unsigned nloc = b.st[0], nx = b.st[1];
        if (nloc == 0u) { xcd_barrier_complete(bar, b.x, nloc, nx); b.st[0] = nloc; b.st[1] = nx; }
        const unsigned old = xb_add(&bar[XB_XSUB(b.x)], 1u);
        const unsigned gen = old / nloc;
        if (old + 1u == (gen + 1u) * nloc) {
            __builtin_amdgcn_fence(__ATOMIC_RELEASE, "agent");
            asm volatile("s_waitcnt vmcnt(0)" ::: "memory");
            const unsigned og = xb_add(&bar[XB_TOP], 1u);
            const unsigned tg = og / nx;
            if (og + 1u == (tg + 1u) * nx) xb_add(&bar[XB_TOPGEN], 1u);
            else XB_SPIN(xb_ld(&bar[XB_TOPGEN]) == tg, bar);
            __builtin_amdgcn_fence(__ATOMIC_ACQUIRE, "agent");
            xb_add(&bar[XB_XGEN(b.x)], 1u);
            asm volatile("s_waitcnt vmcnt(0)" ::: "memory");
        } else {
            XB_SPIN(xb_ld(&bar[XB_XGEN(b.x)]) == gen, bar);
            __builtin_amdgcn_fence(__ATOMIC_ACQUIRE, "agent");
            asm volatile("s_waitcnt vmcnt(0)" ::: "memory");
        }
    }
    __syncthreads();
}

__global__ void __launch_bounds__(NTHREADS, 2) hymba_fwd(Params p) {
    extern __shared__ __attribute__((aligned(16))) unsigned char lds_raw[];
    LAS unsigned char* lds = (LAS unsigned char*)lds_raw;
    cg::grid_group grid = cg::this_grid();
    unsigned char* ws = p.ws;
    volatile LAS unsigned* xb_st = (volatile LAS unsigned*)(lds + pg8::STAGE_BYTES);
    if (threadIdx.x < 4) xb_st[threadIdx.x] = 0u;
    __syncthreads();
    const XcdBarrier xbar = xcd_barrier_post((unsigned*)(ws + WS_BAR), xb_st);
    if (gridDim.x == 0x7fffffffu) grid.sync();
#define GSYNC() xcd_barrier(xbar)
    const int G = gridDim.x, bx = blockIdx.x;
    bf16_t* HB = (bf16_t*)(ws + WS_HB); bf16_t* ACT = (bf16_t*)(ws + WS_ACT); float* HM = (float*)(ws + WS_HMETA); float* SQ = (float*)(ws + WS_SQ);

    prep_phase(p, lds);
    GSYNC();
    {
        pg8::Gemm g{HB, (const bf16_t*)(ws + WS_W1I), MROWS, NFF, D}; pg8::StaticOrder S; S.init(MROWS, NFF, D, G, bx, false);
        EpiSwiglu E{SQ, ACT};
        pg8::gemm_phase(lds, g, S, E);
        {
            const int nbusy = S.nwg % G, nidle = G - nbusy;
            if (nbusy == 0) convert_tiles(p, lds, TT0, TT3, bx, G); else if (bx >= nbusy) convert_tiles(p, lds, TT0, TT3, bx - nbusy, nidle);
        }
    }
    GSYNC();
    {
        pg8::Gemm g{ACT, (const bf16_t*)(ws + WS_W1O), MROWS, D, DFF}; pg8::StaticOrder S; S.init(MROWS, D, DFF, G, bx, true);
        EpiResid E{p.out, HM, HB, SQ + MROWS, 0.5f, 1, p.in[0], p.in[1]};
        pg8::gemm_phase(lds, g, S, E, (float*)(ws + WS_PB));
        GSYNC();
        tail_fixup(E, S, (const float*)(ws + WS_PB));
    }
    GSYNC();
    {
        pg8::Gemm g{HB, (const bf16_t*)(ws + WS_WIN), MROWS, NINP, D}; pg8::StaticOrder S; S.init(MROWS, NINP, D, G, bx, false);
        EpiInproj E{SQ + MROWS, (const float*)(ws + WS_LB), (bf16_t*)(ws + WS_QA), (bf16_t*)(ws + WS_KA), (bf16_t*)(ws + WS_VA), (bf16_t*)(ws + WS_GA),
                    (bf16_t*)(ws + WS_QB), (bf16_t*)(ws + WS_KB), (bf16_t*)(ws + WS_VB), (bf16_t*)(ws + WS_RB), (float*)(ws + WS_LGA), (float*)(ws + WS_ALOW)};
        pg8::gemm_phase(lds, g, S, E);
        {
            const int nbusy = S.nwg % G, nidle = G - nbusy;
            if (nbusy == 0) convert_tiles(p, lds, TT3, TT5, bx, G); else if (bx >= nbusy) convert_tiles(p, lds, TT3, TT5, bx - nbusy, nidle);
        }
    }
    GSYNC();
    scan_sample_phase(p, lds);
    scan_pre_phase(p, lds);
    GSYNC();
    scan_seq_phase(p, lds);
    GSYNC();
    norm_gate_phase(p);
    GSYNC();
    {
        pg8::Gemm g{(const bf16_t*)(ws + WS_QA), (const bf16_t*)(ws + WS_WOUT), ROW_M, D, D}; pg8::StaticOrder S; S.init(ROW_M, D, D, G, bx, true);
        EpiResid E{p.out, HM, HB, SQ + 2 * MROWS, 1.0f, 1, nullptr, nullptr};
        pg8::gemm_phase(lds, g, S, E, (float*)(ws + WS_PB));
        GSYNC();
        tail_fixup(E, S, (const float*)(ws + WS_PB));
    }
    GSYNC();
    {
        pg8::Gemm g{HB, (const bf16_t*)(ws + WS_W2I), ROW_M, NFF, D}; pg8::StaticOrder S; S.init(ROW_M, NFF, D, G, bx, true);
        EpiSwiglu E{SQ + 2 * MROWS, ACT};
        pg8::gemm_phase(lds, g, S, E, (float*)(ws + WS_PB));
        GSYNC();
        tail_fixup(E, S, (const float*)(ws + WS_PB));
    }
    GSYNC();
    {
        pg8::Gemm g{ACT, (const bf16_t*)(ws + WS_W2O), ROW_M, D, DFF}; pg8::StaticOrder S; S.init(ROW_M, D, DFF, G, bx, true);
        EpiResid E{p.out, HM, HB, SQ + 3 * MROWS, 0.5f, 0, nullptr, nullptr};
        pg8::gemm_phase(lds, g, S, E, (float*)(ws + WS_PB));
        GSYNC();
        tail_fixup(E, S, (const float*)(ws + WS_PB));
    }
    GSYNC();
    final_norm_phase(p);
}

constexpr int LDS_BYTES = pg8::STAGE_BYTES + 16;

extern "C" void kernel_launch(void* const* d_in, const int* in_sizes, int n_in, void* d_out, int out_size, void* d_ws, size_t ws_size, hipStream_t stream) {
    static int grid = 0;
    if (grid == 0) {
        if (n_in != 20 || ws_size < WS_END) { fprintf(stderr, "kernel_launch: unexpected inputs (%d) or workspace (%zu < %zu)\n", n_in, ws_size, (size_t)WS_END); grid = -1; return; }
        int dev = 0, cus = 0, per_cu = 0;
        hipGetDevice(&dev);
        hipDeviceGetAttribute(&cus, hipDeviceAttributeMultiprocessorCount, dev);
        hipFuncSetAttribute((const void*)hymba_fwd, hipFuncAttributeMaxDynamicSharedMemorySize, LDS_BYTES);
        hipOccupancyMaxActiveBlocksPerMultiprocessor(&per_cu, (const void*)hymba_fwd, NTHREADS, LDS_BYTES);
        if (per_cu < 1) per_cu = 1;
        (void)hipGetLastError();
        grid = cus;
    }
    if (grid < 0) return;
    Params p{};
    for (int i = 0; i < 20; ++i) p.in[i] = (const float*)d_in[i];
    p.out = (float*)d_out; p.ws = (unsigned char*)d_ws;
    void* args[] = {&p};
    (void)hipMemsetAsync((unsigned char*)d_ws + WS_BAR, 0, XCD_BAR_WORDS * 4, stream);
    hipError_t e = hipLaunchCooperativeKernel((const void*)hymba_fwd, dim3(grid), dim3(NTHREADS), args, LDS_BYTES, stream);
    if (e != hipSuccess) fprintf(stderr, "cooperative launch failed: %s (grid %d)\n", hipGetErrorString(e), grid);
}
```

```cpp
#include <hip/hip_runtime.h>
#include <hip/hip_cooperative_groups.h>
#include <cstdio>
namespace cg = cooperative_groups;

#define LAS __attribute__((address_space(3)))
typedef unsigned short bf16_t;
typedef short bf16x8 __attribute__((ext_vector_type(8)));
typedef float f32x4 __attribute__((ext_vector_type(4)));
typedef float f32x2 __attribute__((ext_vector_type(2)));
typedef unsigned u32x4 __attribute__((ext_vector_type(4)));
typedef unsigned u32x2 __attribute__((ext_vector_type(2)));

constexpr int D = 2048, DFF = 5632, NFF = 2 * DFF, NIN = 7184, NINP = 7424;
constexpr int MROWS = 9472;
constexpr int ROW_S = 8192, ROW_M = 9216, ROW_MEND = 9232;
constexpr float EPS = 1e-6f;
constexpr int NTHREADS = 512;

constexpr size_t OUT_SAP = 18874368, OUT_SBP = 19398656, OUT_SAS = 19922944, OUT_SBS = 36700160;

constexpr size_t SZ_WFI = (size_t)NFF * D * 2, SZ_WFO = (size_t)D * DFF * 2, SZ_WIN = (size_t)NINP * D * 2, SZ_WOUT = (size_t)D * D * 2;
constexpr size_t WS_W1I = 0;
constexpr size_t WS_W1O = WS_W1I + SZ_WFI;
constexpr size_t WS_WIN = WS_W1O + SZ_WFO;
constexpr size_t WS_WOUT = WS_WIN + SZ_WIN;
constexpr size_t WS_W2I = WS_WOUT + SZ_WOUT;
constexpr size_t WS_W2O = WS_W2I + SZ_WFI;
constexpr size_t WS_HB = WS_W2O + SZ_WFO;
constexpr size_t WS_ACT = WS_HB + (size_t)MROWS * D * 2;
constexpr size_t WS_QA = WS_ACT + (size_t)MROWS * DFF * 2;
constexpr size_t WS_KA = WS_QA + (size_t)MROWS * 1024 * 2;
constexpr size_t WS_VA = WS_KA + (size_t)MROWS * 1024 * 2;
constexpr size_t WS_GA = WS_VA + (size_t)MROWS * 1024 * 2;
constexpr size_t WS_LGA = WS_GA + (size_t)MROWS * 1024 * 2;
constexpr size_t WS_QB = WS_LGA + (size_t)MROWS * 1024 * 4;
constexpr size_t WS_KB = WS_QB + (size_t)MROWS * 512 * 2;
constexpr size_t WS_VB = WS_KB + (size_t)MROWS * 512 * 2;
constexpr size_t WS_RB = WS_VB + (size_t)MROWS * 1024 * 2;
constexpr size_t WS_ALOW = WS_RB + (size_t)MROWS * 1024 * 2;
constexpr size_t WS_HMETA = WS_ALOW + (size_t)MROWS * 16 * 4;
constexpr size_t WS_SQ = WS_HMETA + (size_t)256 * D * 4;
constexpr size_t WS_SS = WS_SQ + (size_t)4 * MROWS * 4;
constexpr size_t WS_LB = WS_SS + (size_t)MROWS * 16 * 4;
constexpr size_t WS_SS2 = WS_LB + 4096;
constexpr size_t WS_BAR = WS_SS2 + (size_t)MROWS * 16 * 4;
constexpr size_t WS_SSP = WS_BAR + 16384;
constexpr size_t WS_END = WS_SSP + (size_t)MROWS * 192 * 4;
constexpr size_t WS_OS = WS_HB;
constexpr size_t WS_PB = WS_VA;
constexpr size_t WS_SLOT = WS_ACT;

struct Params { const float* in[20]; float* out; unsigned char* ws; };

typedef __bf16 bf16x2_t __attribute__((ext_vector_type(2)));
__device__ __forceinline__ unsigned cvt_pk_bf16(float lo, float hi) { const f32x2 v = {lo, hi}; return __builtin_bit_cast(unsigned, __builtin_convertvector(v, bf16x2_t)); }
__device__ __forceinline__ bf16_t f2bf(float f) { unsigned u = __float_as_uint(f); u += 0x7FFFu + ((u >> 16) & 1u); return (bf16_t)(u >> 16); }
__device__ __forceinline__ float bf2f(bf16_t b) { return __uint_as_float(((unsigned)b) << 16); }
__device__ __forceinline__ float silu_f(float x) { return x * __builtin_amdgcn_rcpf(1.f + __expf(-x)); }
__device__ __forceinline__ float sigmoid_f(float x) { return __builtin_amdgcn_rcpf(1.f + __expf(-x)); }
__device__ __forceinline__ float row16_sum(float v) {
    v += __int_as_float(__builtin_amdgcn_update_dpp(0, __float_as_int(v), 0xB1, 0xF, 0xF, true));
    v += __int_as_float(__builtin_amdgcn_update_dpp(0, __float_as_int(v), 0x4E, 0xF, 0xF, true));
    v += __int_as_float(__builtin_amdgcn_update_dpp(0, __float_as_int(v), 0x141, 0xF, 0xF, true));
    v += __int_as_float(__builtin_amdgcn_update_dpp(0, __float_as_int(v), 0x140, 0xF, 0xF, true));
    return v;
}
__device__ __forceinline__ u32x4 pack8(const f32x4 a, const f32x4 b) { u32x4 w; w.x = cvt_pk_bf16(a[0], a[1]); w.y = cvt_pk_bf16(a[2], a[3]); w.z = cvt_pk_bf16(b[0], b[1]); w.w = cvt_pk_bf16(b[2], b[3]); return w; }

namespace pg8 {
constexpr int BM = 256, BK = 64, HALF = 128, HTB = HALF * BK * 2, STAGE_BYTES = 8 * HTB, NXCD = 8, WGM = 8;
__device__ __forceinline__ int lds_byte(int r, int c) { const int st = (r >> 4) * 2 + (c >> 5), rr = r & 15, cc = c & 31, ob = rr * 64 + cc * 2; return st * 1024 + (ob ^ (((ob >> 9) & 1) << 5)); }
__device__ __forceinline__ void stage_rc(int b, int& R, int& C) { const int st = b / 1024, sb = b % 1024, swz = sb ^ (((sb >> 9) & 1) << 5); R = (st >> 1) * 16 + swz / 64; C = (st & 1) * 32 + (swz % 64) / 2; }
__device__ __forceinline__ int perm32(int rho) { const int n = rho >> 4, i = rho & 15; return 8 * (i >> 2) + 4 * n + (i & 3); }
struct Unit { int pm, pn, kt0, nkt, part; };
struct Gemm { const bf16_t* A; const bf16_t* Bt; int M, N, K; };
struct StaticOrder {
    int nM, nN, nwg, G, c, nt, full, tail, S;
    __device__ __forceinline__ void init(int M, int N, int K, int G_, int c_, bool split) {
        nM = M / BM; nN = N / BM; nwg = nM * nN; G = G_; c = c_; nt = K / BK; full = nwg; tail = 0; S = 1;
        if (split) { const int f = (nwg / G) * G, tl = nwg - f; if (tl > 0 && G / tl >= 2) { full = f; tail = tl; S = G / tl; } }
    }
    __device__ __forceinline__ void map(int wgid, Unit& u) const {
        { const int q = nwg / NXCD, r = nwg % NXCD, xcd = wgid % NXCD, off = wgid / NXCD; wgid = (xcd < r ? xcd * (q + 1) : r * (q + 1) + (xcd - r) * q) + off; }
        const int nig = WGM * nN, gid = wgid / nig, fm = gid * WGM, gsz = (nM - fm) < WGM ? (nM - fm) : WGM;
        u.pm = fm + ((wgid % nig) % gsz); u.pn = (wgid % nig) / gsz;
    }
    __device__ __forceinline__ bool next(int i, Unit& u) const {
        const long L = (long)i * G + c;
        if (L < full) { map((int)L, u); u.kt0 = 0; u.nkt = nt; u.part = -1; return true; }
        if (tail > 0 && i == full / G) {
            const int np = tail * S; int q;
            if (np % NXCD == 0) { const int per = np / NXCD, x = c % NXCD, ii = c / NXCD; if (ii >= per) return false; q = x * per + ii; } else { if (c >= np) return false; q = c; }
            const int pp = q / tail, j = q - pp * tail;
            map(full + j, u);
            const int pairs = nt / 2, base = pairs / S, rem = pairs % S;
            u.kt0 = 2 * (pp * base + (pp < rem ? pp : rem)); u.nkt = 2 * (base + (pp < rem ? 1 : 0)); u.part = j * S + pp; return true;
        }
        return false;
    }
};

template <class Epi>
__device__ __forceinline__ void gemm_phase(LAS unsigned char* lds, const Gemm g, const StaticOrder& S, const Epi& E, float* pbuf = nullptr) {
    int tid_ = threadIdx.x; asm volatile("" : "+v"(tid_));
    const int tid = tid_, wid = __builtin_amdgcn_readfirstlane(tid >> 6), lane = tid & 63, wr = wid >> 2, wc = wid & 3, fr = lane & 15, fq = lane >> 4;
    const int K = g.K;
    unsigned voffA[2], voffB[2];
#pragma unroll
    for (int i = 0; i < 2; ++i) { int R, C; stage_rc(tid * 16 + i * 8192, R, C); const int Rb = (R & ~31) + perm32(R & 31);
        voffA[i] = (unsigned)(R * K + C) * 2u; voffB[i] = (unsigned)(Rb * K + C) * 2u; }
    const size_t kstep = (size_t)(BK * 2);
    const size_t hstep = (size_t)HALF * K * 2;
    const size_t tstep = 2 * hstep;
    const unsigned ldsw = (unsigned)wid * 1024u;
    const int aoff = lds_byte(wr * 64 + fr, fq * 8), boff = lds_byte(wc * 32 + fr, fq * 8);
#define PG8_SA(b, h) (((b) * 2 + (h)) * HTB)
#define PG8_SB(b, h) ((4 + (b) * 2 + (h)) * HTB)
#define PG8_STAGE(bufoff, gbase, voff) do { _Pragma("unroll") for (int _i = 0; _i < 2; ++_i) \
        __builtin_amdgcn_global_load_lds((const unsigned*)((const char*)(gbase) + (voff)[_i]), (LAS unsigned*)(lds + (bufoff) + ldsw + _i * 8192), 16, 0, 0); } while (0)
#define PG8_LDA(dst, b, h) do { _Pragma("unroll") for (int m = 0; m < 4; ++m) _Pragma("unroll") for (int k = 0; k < 2; ++k) dst[m][k] = *(const LAS bf16x8*)(lds + PG8_SA(b, h) + aoff + m * 2048 + k * 1024); } while (0)
#define PG8_LDB(dst, b, h) do { _Pragma("unroll") for (int n = 0; n < 2; ++n) _Pragma("unroll") for (int k = 0; k < 2; ++k) dst[n][k] = *(const LAS bf16x8*)(lds + PG8_SB(b, h) + boff + n * 2048 + k * 1024); } while (0)
#define PG8_MMA(ai, bj, At, Bt) do { __builtin_amdgcn_s_setprio(1); _Pragma("unroll") for (int m = 0; m < 4; ++m) _Pragma("unroll") for (int n = 0; n < 2; ++n) _Pragma("unroll") for (int k = 0; k < 2; ++k) \
        acc[ai][bj][m][n] = __builtin_amdgcn_mfma_f32_16x16x32_bf16(Bt[n][k], At[m][k], acc[ai][bj][m][n], 0, 0, 0); __builtin_amdgcn_s_setprio(0); } while (0)
#define PG8_WAIT_V(n) asm volatile("s_waitcnt vmcnt(" #n ")" ::: "memory")
#define PG8_WAIT_L(n) asm volatile("s_waitcnt lgkmcnt(" #n ")" ::: "memory")
#define PG8_BAR __builtin_amdgcn_s_barrier()
#define PG8_SCHED __builtin_amdgcn_sched_barrier(0)
    Unit cur, nxt; int ui = 0;
    if (!S.next(0, cur)) return;
    f32x4 acc[2][2][4][2];
#pragma unroll
    for (int a = 0; a < 2; ++a)
#pragma unroll
        for (int b = 0; b < 2; ++b)
#pragma unroll
            for (int m = 0; m < 4; ++m)
#pragma unroll
                for (int n = 0; n < 2; ++n) acc[a][b][m][n] = (f32x4){0.f, 0.f, 0.f, 0.f};
    bf16x8 At[4][2], B0[2][2], B1[2][2];
    float pre[8];
    E.prefetch(cur, wr, fr, pre);
    const char* cA = (const char*)g.A + (size_t)cur.pm * tstep + (size_t)cur.kt0 * kstep; const char* cB = (const char*)g.Bt + (size_t)cur.pn * tstep + (size_t)cur.kt0 * kstep;
    PG8_STAGE(PG8_SB(0, 0), cB, voffB); PG8_STAGE(PG8_SA(0, 0), cA, voffA); PG8_STAGE(PG8_SB(0, 1), cB + hstep, voffB); PG8_STAGE(PG8_SA(0, 1), cA + hstep, voffA);
    if (wr == 1) PG8_BAR;
    PG8_WAIT_V(4); PG8_BAR;
    PG8_STAGE(PG8_SB(1, 0), cB + kstep, voffB); PG8_STAGE(PG8_SA(1, 0), cA + kstep, voffA); PG8_STAGE(PG8_SB(1, 1), cB + hstep + kstep, voffB);
    PG8_WAIT_V(6); PG8_BAR;
    for (;;) {
        const bool has_next = S.next(ui + 1, nxt);
        const char* nA = has_next ? (const char*)g.A + (size_t)nxt.pm * tstep + (size_t)nxt.kt0 * kstep : cA; const char* nB = has_next ? (const char*)g.Bt + (size_t)nxt.pn * tstep + (size_t)nxt.kt0 * kstep : cB;
        const int nt = cur.nkt;
        for (int t = 0; t < nt; t += 2) {
            const bool last = (t == nt - 2);
            const char* a1 = cA + (size_t)(t + 1) * kstep;
            const char* a2 = last ? nA : cA + (size_t)(t + 2) * kstep; const char* b2 = last ? nB : cB + (size_t)(t + 2) * kstep;
            const char* a3 = a2 + kstep; const char* b3 = b2 + kstep;
            PG8_LDB(B0, 0, 0); PG8_SCHED; PG8_LDA(At, 0, 0); PG8_STAGE(PG8_SA(1, 1), a1 + hstep, voffA);
            PG8_WAIT_L(8); PG8_BAR; PG8_WAIT_L(0); PG8_MMA(0, 0, At, B0); PG8_BAR; PG8_SCHED;
            PG8_LDB(B1, 0, 1); PG8_STAGE(PG8_SB(0, 0), b2, voffB);
            PG8_BAR; PG8_WAIT_L(0); PG8_MMA(0, 1, At, B1); PG8_BAR;
            PG8_LDA(At, 0, 1); PG8_STAGE(PG8_SA(0, 0), a2, voffA);
            PG8_BAR; PG8_WAIT_L(0); PG8_MMA(1, 0, At, B0); PG8_BAR; PG8_SCHED;
            PG8_STAGE(PG8_SB(0, 1), b2 + hstep, voffB);
            PG8_WAIT_V(6); PG8_BAR; PG8_MMA(1, 1, At, B1); PG8_BAR;
            PG8_LDB(B0, 1, 0); PG8_SCHED; PG8_LDA(At, 1, 0); PG8_STAGE(PG8_SA(0, 1), a2 + hstep, voffA);
            PG8_WAIT_L(8); PG8_BAR; PG8_WAIT_L(0); PG8_MMA(0, 0, At, B0); PG8_BAR; PG8_SCHED;
            PG8_LDB(B1, 1, 1); PG8_STAGE(PG8_SB(1, 0), b3, voffB);
            PG8_BAR; PG8_WAIT_L(0); PG8_MMA(0, 1, At, B1); PG8_BAR;
            PG8_LDA(At, 1, 1); PG8_STAGE(PG8_SA(1, 0), a3, voffA);
            PG8_BAR; PG8_WAIT_L(0); PG8_MMA(1, 0, At, B0); PG8_BAR; PG8_SCHED;
            PG8_STAGE(PG8_SB(1, 1), b3 + hstep, voffB);
            PG8_WAIT_V(6); PG8_BAR; PG8_MMA(1, 1, At, B1); PG8_BAR;
        }
        if (cur.part >= 0) {
            float* pb = pbuf + (size_t)cur.part * 65536 + (size_t)wid * 8192 + lane * 4;
#pragma unroll
            for (int a = 0; a < 2; ++a)
#pragma unroll
                for (int b = 0; b < 2; ++b)
#pragma unroll
                    for (int m = 0; m < 4; ++m)
#pragma unroll
                        for (int n = 0; n < 2; ++n) *(f32x4*)(pb + (((a * 2 + b) * 4 + m) * 2 + n) * 256) = acc[a][b][m][n];
        } else E(acc, cur, wr, wc, fr, fq, pre);
        if (!has_next) break;
#pragma unroll
        for (int a = 0; a < 2; ++a)
#pragma unroll
            for (int b = 0; b < 2; ++b)
#pragma unroll
                for (int m = 0; m < 4; ++m)
#pragma unroll
                    for (int n = 0; n < 2; ++n) acc[a][b][m][n] = (f32x4){0.f, 0.f, 0.f, 0.f};
        cur = nxt; cA = nA; cB = nB; ++ui;
        E.prefetch(cur, wr, fr, pre);
    }
    PG8_WAIT_V(0);
    if (wr == 0) PG8_BAR;
    PG8_BAR;
#undef PG8_SA
#undef PG8_SB
#undef PG8_STAGE
#undef PG8_LDA
#undef PG8_LDB
#undef PG8_MMA
#undef PG8_WAIT_V
#undef PG8_WAIT_L
#undef PG8_BAR
#undef PG8_SCHED
}
}

struct EpiSwiglu {
    const float* sq; bf16_t* act;
    __device__ __forceinline__ void rowgroup(const f32x4 (&a)[2][2], int pm, int pn, int rt, int wc, int fq) const {
        const int r = pm * 256 + rt;
        const float rs = rsqrtf(sq[r] * (1.0f / D) + EPS);
        f32x4 o0, o1;
#pragma unroll
        for (int j = 0; j < 4; ++j) { o0[j] = silu_f(a[0][0][j] * rs) * (a[1][0][j] * rs); o1[j] = silu_f(a[0][1][j] * rs) * (a[1][1][j] * rs); }
        *(u32x4*)(act + (size_t)r * DFF + pn * 128 + wc * 32 + 8 * fq) = pack8(o0, o1);
    }
    __device__ __forceinline__ void prefetch(const pg8::Unit& u, int wr, int fr, float (&pre)[8]) const {
        const int row0 = u.pm * 256 + wr * 64 + fr;
#pragma unroll
        for (int i = 0; i < 8; ++i) pre[i] = sq[row0 + (i >> 2) * 128 + (i & 3) * 16];
    }
    __device__ __forceinline__ void operator()(const f32x4 (&acc)[2][2][4][2], const pg8::Unit& u, int wr, int wc, int fr, int fq, const float (&pre)[8]) const {
        asm volatile("" : "+v"(fr), "+v"(fq));
        const int row0 = u.pm * 256 + wr * 64 + fr, col0 = u.pn * 128 + wc * 32 + 8 * fq;
        float rsv[8];
#pragma unroll
        for (int i = 0; i < 8; ++i) rsv[i] = rsqrtf(pre[i] * (1.0f / D) + EPS);
#pragma unroll
        for (int ai = 0; ai < 2; ++ai)
#pragma unroll
            for (int m = 0; m < 4; ++m) {
                const int r = row0 + ai * 128 + m * 16;
                const float rs = rsv[ai * 4 + m];
                f32x4 o0, o1;
#pragma unroll
                for (int j = 0; j < 4; ++j) {
                    o0[j] = silu_f(acc[ai][0][m][0][j] * rs) * (acc[ai][1][m][0][j] * rs);
                    o1[j] = silu_f(acc[ai][0][m][1][j] * rs) * (acc[ai][1][m][1][j] * rs);
                }
                *(u32x4*)(act + (size_t)r * DFF + col0) = pack8(o0, o1);
            }
    }
};
struct EpiResid {
    float* out; float* hmeta; bf16_t* hb; float* sq; float scale; int write_hb;
    const float* xin_p; const float* xin_s;
    __device__ __forceinline__ void rowgroup(const f32x4 (&a)[2][2], int pm, int pn, int rt, int wc, int fq) const {
        float* hbase = (pm < 36) ? out + (size_t)pm * 256 * D : hmeta;
        const float* rbase = !xin_p ? hbase : (pm < 32) ? xin_p + (size_t)pm * 256 * D : (pm < 36) ? xin_s + (size_t)(pm - 32) * 256 * D : hmeta;
        const int col0 = pn * 256 + wc * 32 + 8 * fq;
        float* hp = hbase + (size_t)rt * D + col0;
        const float* rp = rbase + (size_t)rt * D + col0;
        f32x4 h[2][2];
#pragma unroll
        for (int bj = 0; bj < 2; ++bj) { h[bj][0] = __builtin_nontemporal_load((const f32x4*)(rp + bj * 128)); h[bj][1] = __builtin_nontemporal_load((const f32x4*)(rp + bj * 128 + 4)); }
        float ss = 0.f;
#pragma unroll
        for (int bj = 0; bj < 2; ++bj) {
            const f32x4 h0 = h[bj][0] + scale * a[bj][0], h1 = h[bj][1] + scale * a[bj][1];
            __builtin_nontemporal_store(h0, (f32x4*)(hp + bj * 128)); __builtin_nontemporal_store(h1, (f32x4*)(hp + bj * 128 + 4));
            ss += (h0[0] * h0[0] + h0[1] * h0[1]) + (h0[2] * h0[2] + h0[3] * h0[3]) + (h1[0] * h1[0] + h1[1] * h1[1]) + (h1[2] * h1[2] + h1[3] * h1[3]);
            if (write_hb) *(u32x4*)(hb + (size_t)(pm * 256 + rt) * D + col0 + bj * 128) = pack8(h0, h1);
        }
        ss += __shfl_xor(ss, 16); ss += __shfl_xor(ss, 32);
        if (fq == 0) atomicAdd(sq + pm * 256 + rt, ss);
    }
    __device__ __forceinline__ void prefetch(const pg8::Unit&, int, int, float (&)[8]) const {}
    __device__ __forceinline__ void operator()(const f32x4 (&acc)[2][2][4][2], const pg8::Unit& u, int wr, int wc, int fr, int fq, const float (&)[8]) const {
        asm volatile("" : "+v"(fr), "+v"(fq));
#pragma unroll
        for (int ai = 0; ai < 2; ++ai)
#pragma unroll
            for (int m = 0; m < 4; ++m) {
                const f32x4 a[2][2] = {{acc[ai][0][m][0], acc[ai][0][m][1]}, {acc[ai][1][m][0], acc[ai][1][m][1]}};
                rowgroup(a, u.pm, u.pn, wr * 64 + fr + ai * 128 + m * 16, wc, fq);
            }
    }
};
template <class Epi>
__device__ __forceinline__ void tail_fixup(const Epi& E, const pg8::StaticOrder& S, const float* pbuf) {
        const int tid = threadIdx.x, wid = __builtin_amdgcn_readfirstlane(tid >> 6), lane = tid & 63, wr = wid >> 2, wc = wid & 3, fr = lane & 15, fq = lane >> 4;
        for (int it = blockIdx.x; it < S.tail * 8; it += gridDim.x) {
            const int j = it >> 3, ai = (it >> 2) & 1, m = it & 3;
            pg8::Unit u; S.map(S.full + j, u);
            f32x4 a[2][2];
#pragma unroll
            for (int bj = 0; bj < 2; ++bj)
#pragma unroll
                for (int n = 0; n < 2; ++n) a[bj][n] = (f32x4){0.f, 0.f, 0.f, 0.f};
            for (int pp0 = 0; pp0 < S.S; pp0 += 8) {
                f32x4 t[8][2][2];
#pragma unroll
                for (int u4 = 0; u4 < 8; ++u4) {
                    const int pp = (pp0 + u4 < S.S) ? pp0 + u4 : pp0;
                    const float* pb = pbuf + (size_t)(j * S.S + pp) * 65536 + (size_t)wid * 8192 + lane * 4;
#pragma unroll
                    for (int bj = 0; bj < 2; ++bj)
#pragma unroll
                        for (int n = 0; n < 2; ++n) t[u4][bj][n] = *(const f32x4*)(pb + (((ai * 2 + bj) * 4 + m) * 2 + n) * 256);
                }
#pragma unroll
                for (int u4 = 0; u4 < 8; ++u4) {
                    const float wgt = (pp0 + u4 < S.S) ? 1.f : 0.f;
#pragma unroll
                    for (int bj = 0; bj < 2; ++bj)
#pragma unroll
                        for (int n = 0; n < 2; ++n) a[bj][n] += wgt * t[u4][bj][n];
                }
            }
            E.rowgroup(a, u.pm, u.pn, wr * 64 + fr + ai * 128 + m * 16, wc, fq);
        }
}
struct EpiInproj {
    const float* sq; const float* lb; bf16_t *QA, *KA, *VA, *GA, *QB, *KB, *VB, *RB; float* LGA; float* ALOW;
    __device__ __forceinline__ void prefetch(const pg8::Unit& u, int wr, int fr, float (&pre)[8]) const {
        const int row0 = u.pm * 256 + wr * 64 + fr;
#pragma unroll
        for (int i = 0; i < 8; ++i) pre[i] = sq[row0 + (i >> 2) * 128 + (i & 3) * 16];
    }
    __device__ __forceinline__ void operator()(const f32x4 (&acc)[2][2][4][2], const pg8::Unit& u, int wr, int wc, int fr, int fq, const float (&pre)[8]) const {
        asm volatile("" : "+v"(fr), "+v"(fq));
        const int row0 = u.pm * 256 + wr * 64 + fr, pn = u.pn;
        const int cl = wc * 32 + 8 * fq;
        const float qs = 0.08838834764831845f;
        float rsv[8];
#pragma unroll
        for (int i = 0; i < 8; ++i) rsv[i] = rsqrtf(pre[i] * (1.0f / D) + EPS);
#pragma unroll
        for (int ai = 0; ai < 2; ++ai)
#pragma unroll
            for (int m = 0; m < 4; ++m) {
                const int r = row0 + ai * 128 + m * 16;
                const float rs = rsv[ai * 4 + m];
#pragma unroll
                for (int bj = 0; bj < 2; ++bj) {
                    f32x4 x0 = acc[ai][bj][m][0] * rs, x1 = acc[ai][bj][m][1] * rs;
                    const int c = pn * 256 + bj * 128 + cl;
                    if (pn < 4) {
#pragma unroll
                        for (int j = 0; j < 4; ++j) { x0[j] = silu_f(x0[j]) * qs; x1[j] = silu_f(x1[j]) * qs; }
                        *(u32x4*)(QA + (size_t)r * 1024 + c) = pack8(x0, x1);
                    } else if (pn < 8) {
                        const int cc = c - 1024;
                        const f32x4 l0 = *(const f32x4*)(lb + cc), l1 = *(const f32x4*)(lb + cc + 4);
                        f32x4 g0, g1;
#pragma unroll
                        for (int j = 0; j < 4; ++j) {
                            const float s0 = sigmoid_f(x0[j]), s1 = sigmoid_f(x1[j]);
                            g0[j] = __logf(l0[j] + (1.f - l0[j]) * s0); g1[j] = __logf(l1[j] + (1.f - l1[j]) * s1);
                        }
                        *(f32x4*)(LGA + (size_t)r * 1024 + cc) = g0; *(f32x4*)(LGA + (size_t)r * 1024 + cc + 4) = g1;
                    } else if (pn < 12) {
                        *(u32x4*)(VA + (size_t)r * 1024 + (c - 2048)) = pack8(x0, x1);
                    } else if (pn < 16) {
#pragma unroll
                        for (int j = 0; j < 4; ++j) { x0[j] = silu_f(x0[j]); x1[j] = silu_f(x1[j]); }
                        *(u32x4*)(GA + (size_t)r * 1024 + (c - 3072)) = pack8(x0, x1);
                    } else if (pn < 18) {
                        x0 *= qs; x1 *= qs;
                        *(u32x4*)(QB + (size_t)r * 512 + (c - 4096)) = pack8(x0, x1);
                    } else if (pn < 20) {
                        *(u32x4*)(KB + (size_t)r * 512 + (c - 4608)) = pack8(x0, x1);
                    } else if (pn < 24) {
                        *(u32x4*)(VB + (size_t)r * 1024 + (c - 5120)) = pack8(x0, x1);
                    } else if (pn < 28) {
#pragma unroll
                        for (int j = 0; j < 4; ++j) { x0[j] = silu_f(x0[j]); x1[j] = silu_f(x1[j]); }
                        *(u32x4*)(RB + (size_t)r * 1024 + (c - 6144)) = pack8(x0, x1);
                    } else {
                        const int cc = c - 7168;
                        if (cc < 16) { *(f32x4*)(ALOW + (size_t)r * 16 + cc) = x0; *(f32x4*)(ALOW + (size_t)r * 16 + cc + 4) = x1; }
                    }
                }
            }
    }
};

constexpr int TT0 = (NFF / 64) * (D / 256), TT1 = TT0 + (D / 64) * (DFF / 256), TT2 = TT1 + (NINP / 64) * (D / 256), TT3 = TT2 + (D / 64) * (D / 256), TT4 = TT3 + (NFF / 64) * (D / 256), TT5 = TT4 + (D / 64) * (DFF / 256);
struct TJob { const float* src; bf16_t* dst; const float* nw; int K, Nsrc, swi, t; };
__device__ __forceinline__ TJob tjob_decode(const Params& p, int t) {
    unsigned char* ws = p.ws; TJob j;
    if (t < TT0)      { j.src = p.in[7];  j.dst = (bf16_t*)(ws + WS_W1I);  j.nw = p.in[6];  j.K = D;   j.Nsrc = NFF; j.swi = 1; j.t = t; }
    else if (t < TT1) { j.src = p.in[8];  j.dst = (bf16_t*)(ws + WS_W1O);  j.nw = nullptr;  j.K = DFF; j.Nsrc = D;   j.swi = 0; j.t = t - TT0; }
    else if (t < TT2) { j.src = p.in[10]; j.dst = (bf16_t*)(ws + WS_WIN);  j.nw = p.in[9];  j.K = D;   j.Nsrc = NIN; j.swi = 0; j.t = t - TT1; }
    else if (t < TT3) { j.src = p.in[15]; j.dst = (bf16_t*)(ws + WS_WOUT); j.nw = nullptr;  j.K = D;   j.Nsrc = D;   j.swi = 0; j.t = t - TT2; }
    else if (t < TT4) { j.src = p.in[17]; j.dst = (bf16_t*)(ws + WS_W2I);  j.nw = p.in[16]; j.K = D;   j.Nsrc = NFF; j.swi = 1; j.t = t - TT3; }
    else              { j.src = p.in[18]; j.dst = (bf16_t*)(ws + WS_W2O);  j.nw = nullptr;  j.K = DFF; j.Nsrc = D;   j.swi = 0; j.t = t - TT4; }
    return j;
}
__device__ __forceinline__ void tjob_load(const TJob& j, f32x4 (&v)[8]) {
    const int tid = threadIdx.x, tk = j.K / 256, n0 = (j.t / tk) * 64, k0 = (j.t % tk) * 256;
    int c0;
    if (j.swi) { const int pn = n0 >> 8, bj = (n0 >> 7) & 1, jj = n0 & 127; c0 = bj * DFF + pn * 128 + jj; } else c0 = n0;
    const int n4 = (tid & 15) * 4, kr = tid >> 4, col = c0 + n4;
#pragma unroll
    for (int i = 0; i < 8; ++i) v[i] = (col < j.Nsrc) ? __builtin_nontemporal_load((const f32x4*)(j.src + (size_t)(k0 + kr + 32 * i) * j.Nsrc + col)) : (f32x4){0.f, 0.f, 0.f, 0.f};
    if (j.nw) {
#pragma unroll
        for (int i = 0; i < 8; ++i) v[i] *= j.nw[k0 + kr + 32 * i];
    }
}
__device__ __forceinline__ void convert_tiles(const Params& p, LAS unsigned char* lds, int tbeg, int tend, int rank, int nranks) {
    LAS float* tile = (LAS float*)lds;
    const int tid = threadIdx.x, n4 = (tid & 15) * 4, kr = tid >> 4, on = tid >> 3, ksb = tid & 7;
    int t = tbeg + rank;
    if (t >= tend) return;
    TJob job = tjob_decode(p, t);
    f32x4 v[8];
    tjob_load(job, v);
    for (;;) {
#pragma unroll
        for (int i = 0; i < 8; ++i) { LAS float* tp = tile + (kr + 32 * i) * 65 + n4; tp[0] = v[i][0]; tp[1] = v[i][1]; tp[2] = v[i][2]; tp[3] = v[i][3]; }
        __syncthreads();
        const int tn = t + nranks; const bool more = tn < tend;
        TJob jn = job;
        if (more) { jn = tjob_decode(p, tn); tjob_load(jn, v); }
        {
            const int tk = job.K / 256, n0 = (job.t / tk) * 64, k0 = (job.t % tk) * 256;
            const bool late = t >= TT1;
#pragma unroll
            for (int jj = 0; jj < 4; ++jj) {
                const int ks = (ksb + 8 * jj) * 8;
                float x[8];
#pragma unroll
                for (int i = 0; i < 8; ++i) x[i] = tile[(ks + i) * 65 + on];
                u32x4 w; w.x = cvt_pk_bf16(x[0], x[1]); w.y = cvt_pk_bf16(x[2], x[3]); w.z = cvt_pk_bf16(x[4], x[5]); w.w = cvt_pk_bf16(x[6], x[7]);
                if (late) __builtin_nontemporal_store(w, (u32x4*)(job.dst + (size_t)(n0 + on) * job.K + k0 + ks));
                else *(u32x4*)(job.dst + (size_t)(n0 + on) * job.K + k0 + ks) = w;
            }
        }
        __syncthreads();
        if (!more) break;
        t = tn; job = jn;
    }
}

__device__ __forceinline__ void prep_phase(const Params& p, LAS unsigned char* lds) {
    unsigned char* ws = p.ws;
    const int tid = threadIdx.x, lane = tid & 63, gw = blockIdx.x * 8 + (tid >> 6), nw = gridDim.x * 8;
    bf16_t* HB = (bf16_t*)(ws + WS_HB); float* HM = (float*)(ws + WS_HMETA); float* SQ = (float*)(ws + WS_SQ);
    for (int r0 = gw; r0 < MROWS; r0 += 4 * nw) {
        f32x4 v[4][8]; const float* src[4];
#pragma unroll
        for (int u = 0; u < 4; ++u) {
            const int r = r0 + u * nw;
            src[u] = r < ROW_S ? p.in[0] + (size_t)r * D : r < ROW_M ? p.in[1] + (size_t)(r - ROW_S) * D : r < ROW_MEND ? p.in[4] + (size_t)(r - ROW_M) * D : nullptr;
#pragma unroll
            for (int i = 0; i < 8; ++i) v[u][i] = src[u] ? __builtin_nontemporal_load((const f32x4*)(src[u] + (i * 64 + lane) * 4)) : (f32x4){0.f, 0.f, 0.f, 0.f};
        }
#pragma unroll
        for (int u = 0; u < 4; ++u) {
            const int r = r0 + u * nw;
            if (r < MROWS) {
                float* hp = HM + (size_t)(r - ROW_M) * D;
                float ss = 0.f;
#pragma unroll
                for (int i = 0; i < 8; ++i) {
                    const int c = (i * 64 + lane) * 4; const f32x4 x = v[u][i];
                    if (r >= ROW_M) *(f32x4*)(hp + c) = x;
                    u32x2 w; w.x = cvt_pk_bf16(x[0], x[1]); w.y = cvt_pk_bf16(x[2], x[3]);
                    *(u32x2*)(HB + (size_t)r * D + c) = w;
                    ss += (x[0] * x[0] + x[1] * x[1]) + (x[2] * x[2] + x[3] * x[3]);
                }
#pragma unroll
                for (int o = 32; o >= 1; o >>= 1) ss += __shfl_xor(ss, o);
                if (lane == 0) SQ[r] = ss;
            }
        }
    }
    { const int gt = blockIdx.x * NTHREADS + tid, ng = gridDim.x * NTHREADS;
      float* LB = (float*)(ws + WS_LB);
      for (int i = gt; i < 3 * MROWS; i += ng) SQ[MROWS + i] = 0.f;
      for (int i = gt; i < 1024; i += ng) { const float l0 = p.in[5][i], l1 = p.in[5][1024 + i]; LB[i] = 1.f / (1.f + expf(l1 - l0)); } }
    convert_tiles(p, lds, 0, TT0, blockIdx.x, gridDim.x);
}

constexpr int SLOT_KD = 16384, SLOT_AM = 32768, SLOT_EB = 40960, SLOT_BYTES = 41472;
constexpr int IMG_KD = 17408, IMG_AM = 35840, IMG_EB = 45056, IMG_BYTES = 45568, IMG_BUF = 49152;

#define LDS_BARRIER() do { asm volatile("s_waitcnt lgkmcnt(0)" ::: "memory"); __builtin_amdgcn_s_barrier(); asm volatile("" ::: "memory"); } while (0)
struct PreItem { int row0, ntok, h; };
__device__ __forceinline__ PreItem pre_decode(int i) { PreItem it; if (i < 1536) { const int bc = i / 12; it.h = i - bc * 12; it.row0 = bc * 64; it.ntok = 64; } else { it.h = i - 1536; it.row0 = ROW_M; it.ntok = 16; } return it; }

struct PreRaw { float lg[16]; bf16_t q[16], k[16]; f32x2 al; float wup[16]; float bal; };
__device__ __forceinline__ void pre_load(const Params& p, const PreItem it, int tid, PreRaw& r) {
    unsigned char* ws = p.ws;
    const bool gla = it.h >= 8; const int head = gla ? it.h - 8 : it.h, ch0 = head * 128, ch = tid & 127, tg = tid >> 7;
    const bf16_t* Q = (const bf16_t*)(ws + (gla ? WS_QB : WS_QA)); const bf16_t* Kp = (const bf16_t*)(ws + (gla ? WS_KB : WS_KA));
    const float* LGA = (const float*)(ws + WS_LGA); const float* ALOW = (const float*)(ws + WS_ALOW);
    const int ldq = gla ? 512 : 1024;
    r.al = (f32x2){0.f, 0.f}; r.bal = 0.f;
    if (gla) {
        const int idx = tid * 2, t = idx >> 4;
        if (t < it.ntok) r.al = *(const f32x2*)(ALOW + (size_t)(it.row0 + t) * 16 + (idx & 15));
#pragma unroll
        for (int j = 0; j < 16; ++j) r.wup[j] = p.in[11][j * 512 + ch0 + ch];
        r.bal = p.in[12][ch0 + ch];
    } else {
#pragma unroll
        for (int j = 0; j < 16; ++j) r.wup[j] = 0.f;
    }
#pragma unroll
    for (int i = 0; i < 16; ++i) {
        const int t = tg * 16 + i; const bool v = t < it.ntok; const size_t o = (size_t)(it.row0 + t) * ldq + ch0 + ch;
        r.lg[i] = (!gla && v) ? __builtin_nontemporal_load(LGA + (size_t)(it.row0 + t) * 1024 + ch0 + ch) : 0.f;
        r.q[i] = v ? __builtin_nontemporal_load(Q + o) : (bf16_t)0; r.k[i] = (gla && v) ? __builtin_nontemporal_load(Kp + o) : (bf16_t)0;
    }
}

template <int DV> struct SRaw { f32x4 S[DV / 16]; float lg[8]; bf16_t q[8], k[8]; float al; float wup[16]; float bal; bf16_t v[DV / 64]; };
template <int DV, bool WITH_S, bool WITH_RAW>
__device__ __forceinline__ void sample_load(const Params& p, int seq, int head, SRaw<DV>& r) {
    constexpr bool GLA = (DV == 256); constexpr int NH = GLA ? 4 : 8, R = DV / 16, VPL = DV / 64;
    unsigned char* ws = p.ws;
    const int tid = threadIdx.x, w = __builtin_amdgcn_readfirstlane(tid >> 6), lane = tid & 63;
    const int row0 = ROW_S + seq * 8, ch0 = head * 128;
    const float* s0 = (GLA ? p.in[3] : p.in[2]) + ((size_t)(seq * NH + head) * 128) * DV;
    const int v4 = GLA ? lane * 4 : (lane & 31) * 4;
    if (WITH_S) {
#pragma unroll
        for (int i = 0; i < R; ++i) { const int k = GLA ? 16 * w + i : 16 * w + 2 * i + (lane >> 5); r.S[i] = __builtin_nontemporal_load((const f32x4*)(s0 + (size_t)k * DV + v4)); }
    }
    if (!WITH_RAW) return;
    r.al = 0.f; r.bal = 0.f;
    if (tid < 128) {
        const int ch = tid;
        const bf16_t* Q = (const bf16_t*)(ws + (GLA ? WS_QB : WS_QA)); const bf16_t* Kp = (const bf16_t*)(ws + (GLA ? WS_KB : WS_KA));
        const int ldq = GLA ? 512 : 1024;
        if (GLA) {
            r.al = ((const float*)(ws + WS_ALOW))[(size_t)row0 * 16 + tid];
#pragma unroll
            for (int j = 0; j < 16; ++j) r.wup[j] = p.in[11][j * 512 + ch0 + ch];
            r.bal = p.in[12][ch0 + ch];
        }
#pragma unroll
        for (int t = 0; t < 8; ++t) {
            r.lg[t] = GLA ? 0.f : __builtin_nontemporal_load((const float*)(ws + WS_LGA) + (size_t)(row0 + t) * 1024 + ch0 + ch);
            r.q[t] = __builtin_nontemporal_load(Q + (size_t)(row0 + t) * ldq + ch0 + ch); r.k[t] = GLA ? __builtin_nontemporal_load(Kp + (size_t)(row0 + t) * ldq + ch0 + ch) : (bf16_t)0;
        }
    }
    {
        const bf16_t* V = (const bf16_t*)(ws + (GLA ? WS_VB : WS_VA));
        const int t = tid >> 6, vv = (tid & 63) * VPL;
#pragma unroll
        for (int i = 0; i < VPL; ++i) r.v[i] = V[(size_t)(row0 + t) * 1024 + head * DV + vv + i];
    }
}
template <int DV>
__device__ __forceinline__ void sample_compute(const Params& p, LAS unsigned char* lds, int seq, int head, const SRaw<DV>& r) {
    constexpr bool GLA = (DV == 256); constexpr int NH = GLA ? 4 : 8, R = DV / 16, VPL = DV / 64;
    unsigned char* ws = p.ws;
    LAS float* QS = (LAS float*)(lds);
    LAS float* KS = (LAS float*)(lds + 4096);
    LAS float* KN = (LAS float*)(lds + 8192);
    LAS float* Q2 = (LAS float*)(lds + 12288);
    LAS float* ES = (LAS float*)(lds + 16384);
    LAS float* AS = (LAS float*)(lds + 16896);
    LAS float* VS = (LAS float*)(lds + 17152);
    LAS float* ORED = (LAS float*)(lds + 25344);
    LAS float* AL = (LAS float*)(lds + 90880);
    const int tid = threadIdx.x, w = __builtin_amdgcn_readfirstlane(tid >> 6), lane = tid & 63;
    const int row0 = ROW_S + seq * 8;
    const int hidx = GLA ? 8 + head : head, ocol = GLA ? 1024 + head * 256 : head * 128;
    float* so = p.out + (GLA ? OUT_SBS : OUT_SAS) + ((size_t)(seq * NH + head) * 128) * DV;
    const int v4 = GLA ? lane * 4 : (lane & 31) * 4;
    if (GLA) { if (tid < 128) AL[tid] = r.al; LDS_BARRIER(); }
    if (tid < 128) {
        const int ch = tid;
        float B[8];
        if (GLA) {
#pragma unroll
            for (int t = 0; t < 8; ++t) {
                float x = r.bal;
#pragma unroll
                for (int j = 0; j < 16; ++j) x += AL[t * 16 + j] * r.wup[j];
                B[t] = (fminf(x, 0.f) - __logf(1.f + __expf(-fabsf(x)))) * (1.0f / 16.0f);
            }
        } else {
#pragma unroll
            for (int t = 0; t < 8; ++t) B[t] = r.lg[t];
        }
        float kk[8];
#pragma unroll
        for (int t = 0; t < 8; ++t) kk[t] = GLA ? bf2f(r.k[t]) : 1.f - __expf(B[t]);
#pragma unroll
        for (int t = 1; t < 8; ++t) B[t] += B[t - 1];
        const float bl = B[7];
#pragma unroll
        for (int t = 0; t < 8; ++t) {
            const float q = bf2f(r.q[t]), k = kk[t];
            const float qb = q * __expf(B[t]);
            QS[ch * 8 + t] = qb; Q2[t * 128 + ch] = qb; KS[ch * 8 + t] = k * __expf(bl - B[t]); KN[t * 128 + ch] = k * __expf(fminf(-B[t], 80.f));
        }
        ES[ch] = __expf(bl);
    }
    {
        const int t = tid >> 6, vv = (tid & 63) * VPL;
#pragma unroll
        for (int i = 0; i < VPL; ++i) VS[t * DV + vv + i] = bf2f(r.v[i]);
    }
    LDS_BARRIER();
    {
        const int pair = tid >> 3, kp = tid & 7, t = pair >> 3, s = pair & 7;
        float a = 0.f;
#pragma unroll
        for (int i = 0; i < 16; ++i) a += Q2[t * 128 + kp * 16 + i] * KN[s * 128 + kp * 16 + i];
        a += __shfl_xor(a, 1); a += __shfl_xor(a, 2); a += __shfl_xor(a, 4);
        if (kp == 0) AS[pair] = (s <= t) ? a : 0.f;
    }
    {
        f32x4 vreg[8], oacc[8];
#pragma unroll
        for (int t = 0; t < 8; ++t) { vreg[t] = *(const LAS f32x4*)(VS + t * DV + v4); oacc[t] = (f32x4){0.f, 0.f, 0.f, 0.f}; }
#pragma unroll
        for (int i = 0; i < R; ++i) {
            const int k = GLA ? 16 * w + i : 16 * w + 2 * i + (lane >> 5);
            const f32x4 q0 = *(const LAS f32x4*)(QS + k * 8), q1 = *(const LAS f32x4*)(QS + k * 8 + 4);
            const f32x4 k0 = *(const LAS f32x4*)(KS + k * 8), k1 = *(const LAS f32x4*)(KS + k * 8 + 4);
            const float e = ES[k];
            const f32x4 sv = r.S[i];
            f32x4 sn = e * sv;
#pragma unroll
            for (int t = 0; t < 4; ++t) { oacc[t] += q0[t] * sv; oacc[t + 4] += q1[t] * sv; sn += k0[t] * vreg[t]; sn += k1[t] * vreg[t + 4]; }
            __builtin_nontemporal_store(sn, (f32x4*)(so + (size_t)k * DV + v4));
        }
        if (!GLA) {
#pragma unroll
            for (int t = 0; t < 8; ++t)
#pragma unroll
                for (int j = 0; j < 4; ++j) oacc[t][j] += __shfl_xor(oacc[t][j], 32);
        }
        if (GLA || lane < 32) {
#pragma unroll
            for (int t = 0; t < 8; ++t) *(LAS f32x4*)(ORED + (w * 8 + t) * DV + v4) = oacc[t];
        }
    }
    LDS_BARRIER();
    {
        const int t = w, vv = lane * VPL;
        float o[VPL]; float ss = 0.f;
#pragma unroll
        for (int i = 0; i < VPL; ++i) {
            float x = 0.f;
#pragma unroll
            for (int ww = 0; ww < 8; ++ww) x += ORED[(ww * 8 + t) * DV + vv + i];
#pragma unroll
            for (int s2 = 0; s2 < 8; ++s2) x += AS[t * 8 + s2] * VS[s2 * DV + vv + i];
            o[i] = x; ss += x * x;
        }
#pragma unroll
        for (int off = 32; off >= 1; off >>= 1) ss += __shfl_xor(ss, off);
        bf16_t* OS = (bf16_t*)(ws + WS_OS) + (size_t)(row0 + t) * D + ocol + vv;
        if (VPL == 2) *(unsigned*)OS = cvt_pk_bf16(o[0], o[1]);
        else { u32x2 pk; pk.x = cvt_pk_bf16(o[0], o[1]); pk.y = cvt_pk_bf16(o[VPL - 2], o[VPL - 1]); *(u32x2*)OS = pk; }
        if (lane < 4) { const f32x4 z = (f32x4){lane == 0 ? ss : 0.f, 0.f, 0.f, 0.f}; *(f32x4*)((float*)(ws + WS_SSP) + ((size_t)(row0 + t) * 12 + hidx) * 16 + lane * 4) = z; }
    }
    LDS_BARRIER();
}
template <int DV>
__device__ __forceinline__ void sample_loop(const Params& p, LAS unsigned char* lds) {
    constexpr int NHD = (DV == 256) ? 4 : 8, TOTAL = 128 * NHD;
    const int G = gridDim.x;
    constexpr bool PS = (DV == 128);
    int it = blockIdx.x;
    if (it >= TOTAL) return;
    SRaw<DV> nxt;
    sample_load<DV, PS, true>(p, it / NHD, it % NHD, nxt);
    for (; it < TOTAL; it += G) {
        SRaw<DV> cur = nxt;
        if (!PS) sample_load<DV, true, false>(p, it / NHD, it % NHD, cur);
        if (it + G < TOTAL) sample_load<DV, PS, true>(p, (it + G) / NHD, (it + G) % NHD, nxt);
        sample_compute<DV>(p, lds, it / NHD, it % NHD, cur);
    }
}

__device__ __forceinline__ int pre_item_of(int bx, int j, int G) {
    if (G != 256) { const int i = bx + j * G; return i < 1548 ? i : -1; }
    if (j < 6) {
        const int x = bx & 7, l = (bx >> 3) + 32 * j, pair = l >> 5, chunk = l & 31;
        const bool gla = pair >= 4;
        const int grp = gla ? 2 * x + (pair - 4) : 4 * x + pair;
        const int b = gla ? grp >> 2 : grp >> 3, hidx = gla ? 8 + (grp & 3) : grp & 7;
        return (b * 32 + chunk) * 12 + hidx;
    }
    return (j == 6 && bx < 12) ? 1536 + bx : -1;
}
__device__ __forceinline__ void scan_pre_phase(const Params& p, LAS unsigned char* lds) {
    unsigned char* ws = p.ws;
    LAS bf16_t* Qt = (LAS bf16_t*)(lds);
    LAS bf16_t* Kt = (LAS bf16_t*)(lds + 17408);
    LAS float* Bc = (LAS float*)(lds + 34816);
    LAS float* AL = (LAS float*)(lds + 36864);
    const int tid = threadIdx.x, w = __builtin_amdgcn_readfirstlane(tid >> 6), lane = tid & 63, fr = lane & 15, fq = lane >> 4;
    const int ch = tid & 127, tg = tid >> 7, ti = w >> 1, sjb = (w & 1) * 2;
    PreRaw raw;
    const int G = gridDim.x, bx = blockIdx.x;
    int jj = 0, i = pre_item_of(bx, 0, G);
    if (i >= 0) pre_load(p, pre_decode(i), tid, raw);
    for (; i >= 0; ) {
        const int inext = pre_item_of(bx, ++jj, G);
        const PreItem it = pre_decode(i);
        const bool gla = it.h >= 8;
        unsigned char* slot = ws + WS_SLOT + (size_t)i * SLOT_BYTES;
        float c[16];
        if (gla) {
            *(LAS f32x2*)(AL + tid * 2) = raw.al;
            LDS_BARRIER();
#pragma unroll
            for (int j = 0; j < 16; ++j) {
                const int t = tg * 16 + j;
                float x = raw.bal;
#pragma unroll
                for (int jj = 0; jj < 16; ++jj) x += AL[t * 16 + jj] * raw.wup[jj];
                const float ls = fminf(x, 0.f) - __logf(1.f + __expf(-fabsf(x)));
                c[j] = (t < it.ntok) ? ls * (1.0f / 16.0f) : 0.f;
            }
        } else {
#pragma unroll
            for (int j = 0; j < 16; ++j) c[j] = raw.lg[j];
        }
        float kq[16];
#pragma unroll
        for (int j = 0; j < 16; ++j) kq[j] = gla ? bf2f(raw.k[j]) : 1.f - __expf(c[j]);
#pragma unroll
        for (int j = 1; j < 16; ++j) c[j] += c[j - 1];
        Bc[tg * 128 + ch] = c[15];
        LDS_BARRIER();
        const float t0 = Bc[ch], t1 = Bc[128 + ch], t2 = Bc[256 + ch], t3 = Bc[384 + ch];
        const float off = tg == 0 ? 0.f : tg == 1 ? t0 : tg == 2 ? t0 + t1 : t0 + t1 + t2;
        const float rr = t0 + t1, bl = (t0 + t1) + (t2 + t3);
        const float er = __expf(rr), el = __expf(bl - rr);
        if (tg == 0) ((float*)(slot + SLOT_EB))[ch] = __expf(bl);
        {
            float kd[16];
            bf16_t* qbg = (bf16_t*)slot;
#pragma unroll
            for (int j = 0; j < 16; ++j) {
                const int t = tg * 16 + j;
                const float qv = bf2f(raw.q[j]), kv = kq[j];
                const float B = c[j] + off;
                const float eA = __expf(fminf(B - rr, 80.f)), eB = __expf(fminf(rr - B, 80.f));
                const float qt = qv * eA, kt = kv * eB;
                Qt[t * 136 + ch] = f2bf(qt); Kt[t * 136 + ch] = f2bf(kt);
                qbg[t * 128 + ch] = f2bf(qt * er);
                kd[j] = kt * el;
            }
            u32x4 w0, w1;
            w0.x = cvt_pk_bf16(kd[0], kd[1]); w0.y = cvt_pk_bf16(kd[2], kd[3]); w0.z = cvt_pk_bf16(kd[4], kd[5]); w0.w = cvt_pk_bf16(kd[6], kd[7]);
            w1.x = cvt_pk_bf16(kd[8], kd[9]); w1.y = cvt_pk_bf16(kd[10], kd[11]); w1.z = cvt_pk_bf16(kd[12], kd[13]); w1.w = cvt_pk_bf16(kd[14], kd[15]);
            bf16_t* kdg = (bf16_t*)(slot + SLOT_KD) + ch * 64 + tg * 16;
            *(u32x4*)kdg = w0; *(u32x4*)(kdg + 8) = w1;
        }
        if (inext >= 0) pre_load(p, pre_decode(inext), tid, raw);
        LDS_BARRIER();
        bf16_t* amg = (bf16_t*)(slot + SLOT_AM);
#pragma unroll
        for (int q = 0; q < 2; ++q) {
            const int sj = sjb + q;
            f32x4 aacc = (f32x4){0.f, 0.f, 0.f, 0.f};
#pragma unroll
            for (int kk = 0; kk < 4; ++kk) {
                const bf16x8 a = *(const LAS bf16x8*)(Qt + (16 * ti + fr) * 136 + 32 * kk + 8 * fq);
                const bf16x8 b = *(const LAS bf16x8*)(Kt + (16 * sj + fr) * 136 + 32 * kk + 8 * fq);
                aacc = __builtin_amdgcn_mfma_f32_16x16x32_bf16(a, b, aacc, 0, 0, 0);
            }
#pragma unroll
            for (int j = 0; j < 4; ++j) { const int t = 16 * ti + 4 * fq + j, s = 16 * sj + fr; amg[t * 64 + s] = f2bf(s <= t ? aacc[j] : 0.f); }
        }
        LDS_BARRIER();
        i = inext;
    }
}
__device__ __forceinline__ void scan_sample_phase(const Params& p, LAS unsigned char* lds) {
    sample_loop<128>(p, lds);
    sample_loop<256>(p, lds);
}

__device__ __forceinline__ void scan_seq_phase(const Params& p, LAS unsigned char* lds) {
    unsigned char* ws = p.ws;
    LAS bf16_t* Vt = (LAS bf16_t*)(lds + 2 * IMG_BUF);
    LAS bf16_t* St = (LAS bf16_t*)(lds + 2 * IMG_BUF + 4608);
    const int tid = threadIdx.x, w = __builtin_amdgcn_readfirstlane(tid >> 6), lane = tid & 63, fr = lane & 15, fq = lane >> 4;
    const int ti = w >> 1, vj = w & 1, vi = w >> 2, kj0 = (w & 3) * 2;
    unsigned soff[6];
#pragma unroll
    for (int i = 0; i < 6; ++i) {
        const int P = (tid + 512 * i) * 16; unsigned o = 0;
        if (P < IMG_KD) { const int row = P / 272, cb = P % 272; o = cb < 256 ? row * 256 + cb : 0; }
        else if (P < IMG_AM) { const int Pp = P - IMG_KD, row = Pp / 144, cb = Pp % 144; o = cb < 128 ? SLOT_KD + row * 128 + cb : 0; }
        else if (P < IMG_EB) { const int Pp = P - IMG_AM, row = Pp / 144, cb = Pp % 144; o = cb < 128 ? SLOT_AM + row * 128 + cb : 0; }
        else if (P < IMG_BYTES) o = SLOT_EB + (P - IMG_EB);
        soff[i] = o;
    }
    bf16_t* OS = (bf16_t*)(ws + WS_OS); float* SSP = (float*)(ws + WS_SSP);
#define SEQ_DMA(SLOTI, BUF) do { const unsigned char* sb_ = ws + WS_SLOT + (size_t)(SLOTI) * SLOT_BYTES; _Pragma("unroll") for (int i_ = 0; i_ < 6; ++i_) \
        __builtin_amdgcn_global_load_lds((const unsigned*)(sb_ + soff[i_]), (LAS unsigned*)((BUF) + w * 1024 + i_ * 8192), 16, 0, 0); } while (0)
    for (int item = blockIdx.x; item < 256; item += gridDim.x) {
        const int xcd = item & 7, ii = item >> 3;
        const bool gla = ii >= 16;
        const int grp = gla ? xcd * 2 + ((ii - 16) >> 3) : xcd * 4 + (ii >> 2);
        const int vs = gla ? (ii - 16) & 7 : ii & 3;
        const int b = gla ? grp >> 2 : grp >> 3, head = gla ? grp & 3 : grp & 7;
        const int DV = gla ? 256 : 128, NH = gla ? 4 : 8;
        const int vcol = head * DV + vs * 32, ocol = (gla ? 1024 : 0) + vcol, hidx = gla ? 8 + head : head;
        const bf16_t* V = (const bf16_t*)(ws + (gla ? WS_VB : WS_VA));
        f32x4 Sacc[2];
        Sacc[0] = (f32x4){0.f, 0.f, 0.f, 0.f}; Sacc[1] = Sacc[0];
#pragma unroll
        for (int q = 0; q < 2; ++q)
#pragma unroll
            for (int j = 0; j < 4; ++j) St[(16 * vi + 4 * fq + j) * 136 + 16 * (kj0 + q) + fr] = (bf16_t)0;
        const int sv = tid >> 3, v4 = (tid & 7) * 4;
        u32x2 vr;
        SEQ_DMA(1536 + hidx, lds);
        vr = (sv < 16) ? *(const u32x2*)(V + (size_t)(ROW_M + sv) * 1024 + vcol + v4) : (u32x2){0u, 0u};
        f32x4 oprev = (f32x4){0.f, 0.f, 0.f, 0.f};
        for (int step = 0; step < 33; ++step) {
            LAS unsigned char* cur = lds + (step & 1) * IMG_BUF;
            Vt[(v4 + 0) * 72 + sv] = (bf16_t)(vr.x & 0xffffu); Vt[(v4 + 1) * 72 + sv] = (bf16_t)(vr.x >> 16);
            Vt[(v4 + 2) * 72 + sv] = (bf16_t)(vr.y & 0xffffu); Vt[(v4 + 3) * 72 + sv] = (bf16_t)(vr.y >> 16);
            asm volatile("s_waitcnt vmcnt(0) lgkmcnt(0)" ::: "memory");
            __builtin_amdgcn_s_barrier(); asm volatile("" ::: "memory");
            if (step + 1 < 33) {
                SEQ_DMA((b * 32 + step) * 12 + hidx, lds + ((step + 1) & 1) * IMG_BUF);
                vr = __builtin_nontemporal_load((const u32x2*)(V + (size_t)(b * 2048 + step * 64 + sv) * 1024 + vcol + v4));
            }
            asm volatile("" ::: "memory");
            if (step > 1) {
                const int row0 = b * 2048 + (step - 2) * 64;
                float s2[4];
#pragma unroll
                for (int j = 0; j < 4; ++j) s2[j] = row16_sum(oprev[j] * oprev[j]);
#pragma unroll
                for (int j = 0; j < 4; ++j) OS[(size_t)(row0 + 16 * ti + 4 * fq + j) * D + ocol + 16 * vj + fr] = f2bf(oprev[j]);
#pragma unroll
                for (int j = 0; j < 4; ++j) SSP[((size_t)(row0 + 16 * ti + 4 * fq + j) * 12 + hidx) * 16 + vs * 2 + vj] = s2[j];
            }
            asm volatile("" ::: "memory");
            const LAS bf16_t* Qb = (const LAS bf16_t*)cur; const LAS bf16_t* Kd = (const LAS bf16_t*)(cur + IMG_KD);
            const LAS bf16_t* Am = (const LAS bf16_t*)(cur + IMG_AM); const LAS float* EB = (const LAS float*)(cur + IMG_EB);
            f32x4 oacc = (f32x4){0.f, 0.f, 0.f, 0.f};
#pragma unroll
            for (int kk = 0; kk < 4; ++kk) {
                const bf16x8 a = *(const LAS bf16x8*)(Qb + (16 * ti + fr) * 136 + 32 * kk + 8 * fq);
                const bf16x8 bb = *(const LAS bf16x8*)(St + (16 * vj + fr) * 136 + 32 * kk + 8 * fq);
                oacc = __builtin_amdgcn_mfma_f32_16x16x32_bf16(a, bb, oacc, 0, 0, 0);
            }
#pragma unroll
            for (int s2 = 0; s2 < 2; ++s2) {
                const bf16x8 a = *(const LAS bf16x8*)(Am + (16 * ti + fr) * 72 + 32 * s2 + 8 * fq);
                const bf16x8 bb = *(const LAS bf16x8*)(Vt + (16 * vj + fr) * 72 + 32 * s2 + 8 * fq);
                oacc = __builtin_amdgcn_mfma_f32_16x16x32_bf16(a, bb, oacc, 0, 0, 0);
            }
#pragma unroll
            for (int q = 0; q < 2; ++q) {
                const int kj = kj0 + q;
                const float e = EB[16 * kj + fr];
                Sacc[q] *= e;
#pragma unroll
                for (int s2 = 0; s2 < 2; ++s2) {
                    const bf16x8 a = *(const LAS bf16x8*)(Vt + (16 * vi + fr) * 72 + 32 * s2 + 8 * fq);
                    const bf16x8 bb = *(const LAS bf16x8*)(Kd + (16 * kj + fr) * 72 + 32 * s2 + 8 * fq);
                    Sacc[q] = __builtin_amdgcn_mfma_f32_16x16x32_bf16(a, bb, Sacc[q], 0, 0, 0);
                }
            }
            oprev = oacc;
            asm volatile("s_waitcnt lgkmcnt(0)" ::: "memory"); __builtin_amdgcn_s_barrier(); asm volatile("" ::: "memory");
#pragma unroll
            for (int q = 0; q < 2; ++q)
#pragma unroll
                for (int j = 0; j < 4; ++j) St[(16 * vi + 4 * fq + j) * 136 + 16 * (kj0 + q) + fr] = f2bf(Sacc[q][j]);
        }
        {
            const int row0 = b * 2048 + 31 * 64;
            float s2[4];
#pragma unroll
            for (int j = 0; j < 4; ++j) s2[j] = row16_sum(oprev[j] * oprev[j]);
#pragma unroll
            for (int j = 0; j < 4; ++j) OS[(size_t)(row0 + 16 * ti + 4 * fq + j) * D + ocol + 16 * vj + fr] = f2bf(oprev[j]);
#pragma unroll
            for (int j = 0; j < 4; ++j) SSP[((size_t)(row0 + 16 * ti + 4 * fq + j) * 12 + hidx) * 16 + vs * 2 + vj] = s2[j];
        }
        {
            float* so = p.out + (gla ? OUT_SBP : OUT_SAP) + ((size_t)(b * NH + head) * 128) * DV + vs * 32 + 16 * vi + 4 * fq;
#pragma unroll
            for (int q = 0; q < 2; ++q) *(f32x4*)(so + (size_t)(16 * (kj0 + q) + fr) * DV) = Sacc[q];
        }
        __syncthreads();
    }
#undef SEQ_DMA
}

__device__ __forceinline__ void norm_gate_phase(const Params& p) {
    unsigned char* ws = p.ws;
    const bf16_t* OS = (const bf16_t*)(ws + WS_OS); const float* SSP = (const float*)(ws + WS_SSP);
    const bf16_t* GA = (const bf16_t*)(ws + WS_GA); const bf16_t* RB = (const bf16_t*)(ws + WS_RB);
    bf16_t* OB = (bf16_t*)(ws + WS_QA);
    const int gt = blockIdx.x * NTHREADS + threadIdx.x, ng = gridDim.x * NTHREADS;
    constexpr int NIT = ROW_M * 256;
    for (int i0 = gt; i0 < NIT; i0 += 8 * ng) {
        u32x4 ov[8], gv[8]; float ssv[8];
#pragma unroll
        for (int u = 0; u < 8; ++u) {
            const int i = i0 + u * ng;
            if (i < NIT) {
                const int r = i >> 8, c = (i & 255) * 8; const bool gla = c >= 1024;
                ov[u] = __builtin_nontemporal_load((const u32x4*)(OS + (size_t)r * D + c));
                gv[u] = gla ? __builtin_nontemporal_load((const u32x4*)(RB + (size_t)r * 1024 + (c - 1024))) : __builtin_nontemporal_load((const u32x4*)(GA + (size_t)r * 1024 + c));
                {   const float* sp = SSP + ((size_t)r * 12 + (gla ? 8 + ((c - 1024) >> 8) : c >> 7)) * 16;
                    const f32x4 q0 = *(const f32x4*)sp, q1 = *(const f32x4*)(sp + 4);
                    float t = (q0[0] + q0[1]) + (q0[2] + q0[3]) + (q1[0] + q1[1]) + (q1[2] + q1[3]);
                    if (gla) { const f32x4 q2 = *(const f32x4*)(sp + 8), q3 = *(const f32x4*)(sp + 12); t += (q2[0] + q2[1]) + (q2[2] + q2[3]) + (q3[0] + q3[1]) + (q3[2] + q3[3]); }
                    ssv[u] = t; }
            }
        }
#pragma unroll
        for (int u = 0; u < 8; ++u) {
            const int i = i0 + u * ng;
            if (i < NIT) {
                const int r = i >> 8, c = (i & 255) * 8; const bool gla = c >= 1024;
                const float sc = rsqrtf(ssv[u] * (gla ? 1.0f / 256.0f : 1.0f / 128.0f) + EPS);
                const float* gn = gla ? p.in[14] + (c - 1024) : p.in[13] + c;
                const f32x4 n0 = *(const f32x4*)(gn), n1 = *(const f32x4*)(gn + 4);
                const u32x4 gt4 = gv[u], o4 = ov[u];
                f32x4 g0, g1, o0, o1;
                g0[0] = __uint_as_float(gt4.x << 16); g0[1] = __uint_as_float(gt4.x & 0xffff0000u); g0[2] = __uint_as_float(gt4.y << 16); g0[3] = __uint_as_float(gt4.y & 0xffff0000u);
                g1[0] = __uint_as_float(gt4.z << 16); g1[1] = __uint_as_float(gt4.z & 0xffff0000u); g1[2] = __uint_as_float(gt4.w << 16); g1[3] = __uint_as_float(gt4.w & 0xffff0000u);
                o0[0] = __uint_as_float(o4.x << 16); o0[1] = __uint_as_float(o4.x & 0xffff0000u); o0[2] = __uint_as_float(o4.y << 16); o0[3] = __uint_as_float(o4.y & 0xffff0000u);
                o1[0] = __uint_as_float(o4.z << 16); o1[1] = __uint_as_float(o4.z & 0xffff0000u); o1[2] = __uint_as_float(o4.w << 16); o1[3] = __uint_as_float(o4.w & 0xffff0000u);
                *(u32x4*)(OB + (size_t)r * D + c) = pack8(o0 * sc * n0 * g0, o1 * sc * n1 * g1);
            }
        }
    }
}

__device__ __forceinline__ void final_norm_phase(const Params& p) {
    const float* SQ3 = (const float*)(p.ws + WS_SQ) + 3 * MROWS;
    const float* fn = p.in[19];
    const int gt = blockIdx.x * NTHREADS + threadIdx.x, ng = gridDim.x * NTHREADS;
    constexpr int NIT = ROW_M * 512;
    for (int i0 = gt; i0 < NIT; i0 += 8 * ng) {
        f32x4 h[8]; float sq[8];
#pragma unroll
        for (int u = 0; u < 8; ++u) { const int i = i0 + u * ng; if (i < NIT) { h[u] = *(const f32x4*)(p.out + (size_t)i * 4); sq[u] = SQ3[i >> 9]; } }
#pragma unroll
        for (int u = 0; u < 8; ++u) { const int i = i0 + u * ng; if (i < NIT) { const f32x4 f = *(const f32x4*)(fn + (i & 511) * 4); __builtin_nontemporal_store(h[u] * rsqrtf(sq[u] * (1.0f / D) + EPS) * f, (f32x4*)(p.out + (size_t)i * 4)); } }
    }
}

#define XB_TMO      128
#define XB_XCNT(j)  (256  + 64 * (j))
#define XB_XSUB(j)  (1280 + 64 * (j))
#define XB_XGEN(j)  (2304 + 64 * (j))
#define XB_TOP      3328
#define XB_TOPGEN   3392
#define XCD_BAR_WORDS 3456
#define XB_SPIN_CAP (1u << 20)
__device__ __forceinline__ unsigned xb_ld(unsigned* p)              { return __hip_atomic_load(p, __ATOMIC_RELAXED, __HIP_MEMORY_SCOPE_AGENT); }
__device__ __forceinline__ unsigned xb_add(unsigned* p, unsigned v) { return __hip_atomic_fetch_add(p, v, __ATOMIC_RELAXED, __HIP_MEMORY_SCOPE_AGENT); }
__device__ __forceinline__ unsigned xb_xcc_id() { return (unsigned)__builtin_amdgcn_s_getreg((3 << 11) | 20) & 0xFu; }
#define XB_SPIN(cond, bar) do { unsigned _sp = 0; while (cond) { __builtin_amdgcn_s_sleep(6); \
    if ((++_sp & 255u) == 0u) { if (xb_ld(&(bar)[XB_TMO])) break; if (_sp > XB_SPIN_CAP) { atomicAdd(&(bar)[XB_TMO], 1u); break; } } } } while (0)
struct XcdBarrier { unsigned* bar; unsigned x; volatile LAS unsigned* st; };
__device__ __forceinline__ XcdBarrier xcd_barrier_post(unsigned* bar, volatile LAS unsigned* st) {
    XcdBarrier b; b.bar = bar; b.x = xb_xcc_id(); b.st = st;
    if (threadIdx.x == 0) (void)xb_add(&bar[XB_XCNT(b.x)], 1u);
    return b;
}
__device__ __forceinline__ void xcd_barrier_complete(unsigned* bar, unsigned x, unsigned& nloc, unsigned& nx) {
    const unsigned G = gridDim.x * gridDim.y * gridDim.z;
    unsigned sum, cnt, mine, sp = 0u;
    for (;;) {
        sum = 0u; cnt = 0u; mine = 0u;
#pragma unroll
        for (unsigned j = 0; j < 16; ++j) { const unsigned c = xb_ld(&bar[XB_XCNT(j)]); sum += c; cnt += (c > 0u) ? 1u : 0u; mine = (j == x) ? c : mine; }
        if (sum == G) break;
        __builtin_amdgcn_s_sleep(1);
        if ((++sp & 255u) == 0u) { if (xb_ld(&bar[XB_TMO])) break; if (sp > XB_SPIN_CAP) { atomicAdd(&bar[XB_TMO], 1u); break; } }
    }
    nloc = mine > 0u ? mine : 1u; nx = cnt > 0u ? cnt : 1u;
}
__device__ __forceinline__ void xcd_barrier(const XcdBarrier& b) {
    asm volatile("s_waitcnt vmcnt(0)" ::: "memory");
    __syncthreads();
    if (threadIdx.x == 0) {
        unsigned* bar = b.bar;
        __builtin_amdgcn_s_waitcnt(0);
        unsigned nloc = b.st[0], nx = b.st[1];
        if (nloc == 0u) { xcd_barrier_complete(bar, b.x, nloc, nx); b.st[0] = nloc; b.st[1] = nx; }
        const unsigned old = xb_add(&bar[XB_XSUB(b.x)], 1u);
        const unsigned gen = old / nloc;
        if (old + 1u == (gen + 1u) * nloc) {
            __builtin_amdgcn_fence(__ATOMIC_RELEASE, "agent");
            asm volatile("s_waitcnt vmcnt(0)" ::: "memory");
            const unsigned og = xb_add(&bar[XB_TOP], 1u);
            const unsigned tg = og / nx;
            if (og + 1u == (tg + 1u) * nx) xb_add(&bar[XB_TOPGEN], 1u);
            else XB_SPIN(xb_ld(&bar[XB_TOPGEN]) == tg, bar);
            __builtin_amdgcn_fence(__ATOMIC_ACQUIRE, "agent");
            xb_add(&bar[XB_XGEN(b.x)], 1u);
            asm volatile("s_waitcnt vmcnt(0)" ::: "memory");
        } else {
            XB_SPIN(xb_ld(&bar[XB_XGEN(b.x)]) == gen, bar);
            __builtin_amdgcn_fence(__ATOMIC_ACQUIRE, "agent");
            asm volatile("s_waitcnt vmcnt(0)" ::: "memory");
        }
    }
    __syncthreads();
}

__global__ void __launch_bounds__(NTHREADS, 2) hymba_fwd(Params p) {
    extern __shared__ __attribute__((aligned(16))) unsigned char lds_raw[];
    LAS unsigned char* lds = (LAS unsigned char*)lds_raw;
    cg::grid_group grid = cg::this_grid();
    unsigned char* ws = p.ws;
    volatile LAS unsigned* xb_st = (volatile LAS unsigned*)(lds + pg8::STAGE_BYTES);
    if (threadIdx.x < 4) xb_st[threadIdx.x] = 0u;
    __syncthreads();
    const XcdBarrier xbar = xcd_barrier_post((unsigned*)(ws + WS_BAR), xb_st);
    if (gridDim.x == 0x7fffffffu) grid.sync();
#define GSYNC() xcd_barrier(xbar)
    const int G = gridDim.x, bx = blockIdx.x;
    bf16_t* HB = (bf16_t*)(ws + WS_HB); bf16_t* ACT = (bf16_t*)(ws + WS_ACT); float* HM = (float*)(ws + WS_HMETA); float* SQ = (float*)(ws + WS_SQ);

    prep_phase(p, lds);
    GSYNC();
    {
        pg8::Gemm g{HB, (const bf16_t*)(ws + WS_W1I), MROWS, NFF, D}; pg8::StaticOrder S; S.init(MROWS, NFF, D, G, bx, false);
        EpiSwiglu E{SQ, ACT};
        pg8::gemm_phase(lds, g, S, E);
        {
            const int nbusy = S.nwg % G, nidle = G - nbusy;
            if (nbusy == 0) convert_tiles(p, lds, TT0, TT3, bx, G); else if (bx >= nbusy) convert_tiles(p, lds, TT0, TT3, bx - nbusy, nidle);
        }
    }
    GSYNC();
    {
        pg8::Gemm g{ACT, (const bf16_t*)(ws + WS_W1O), MROWS, D, DFF}; pg8::StaticOrder S; S.init(MROWS, D, DFF, G, bx, true);
        EpiResid E{p.out, HM, HB, SQ + MROWS, 0.5f, 1, p.in[0], p.in[1]};
        pg8::gemm_phase(lds, g, S, E, (float*)(ws + WS_PB));
        GSYNC();
        tail_fixup(E, S, (const float*)(ws + WS_PB));
    }
    GSYNC();
    {
        pg8::Gemm g{HB, (const bf16_t*)(ws + WS_WIN), MROWS, NINP, D}; pg8::StaticOrder S; S.init(MROWS, NINP, D, G, bx, false);
        EpiInproj E{SQ + MROWS, (const float*)(ws + WS_LB), (bf16_t*)(ws + WS_QA), (bf16_t*)(ws + WS_KA), (bf16_t*)(ws + WS_VA), (bf16_t*)(ws + WS_GA),
                    (bf16_t*)(ws + WS_QB), (bf16_t*)(ws + WS_KB), (bf16_t*)(ws + WS_VB), (bf16_t*)(ws + WS_RB), (float*)(ws + WS_LGA), (float*)(ws + WS_ALOW)};
        pg8::gemm_phase(lds, g, S, E);
        {
            const int nbusy = S.nwg % G, nidle = G - nbusy;
            if (nbusy == 0) convert_tiles(p, lds, TT3, TT5, bx, G); else if (bx >= nbusy) convert_tiles(p, lds, TT3, TT5, bx - nbusy, nidle);
        }
    }
    GSYNC();
    scan_sample_phase(p, lds);
    scan_pre_phase(p, lds);
    GSYNC();
    scan_seq_phase(p, lds);
    GSYNC();
    norm_gate_phase(p);
    GSYNC();
    {
        pg8::Gemm g{(const bf16_t*)(ws + WS_QA), (const bf16_t*)(ws + WS_WOUT), ROW_M, D, D}; pg8::StaticOrder S; S.init(ROW_M, D, D, G, bx, true);
        EpiResid E{p.out, HM, HB, SQ + 2 * MROWS, 1.0f, 1, nullptr, nullptr};
        pg8::gemm_phase(lds, g, S, E, (float*)(ws + WS_PB));
        GSYNC();
        tail_fixup(E, S, (const float*)(ws + WS_PB));
    }
    GSYNC();
    {
        pg8::Gemm g{HB, (const bf16_t*)(ws + WS_W2I), ROW_M, NFF, D}; pg8::StaticOrder S; S.init(ROW_M, NFF, D, G, bx, true);
        EpiSwiglu E{SQ + 2 * MROWS, ACT};
        pg8::gemm_phase(lds, g, S, E, (float*)(ws + WS_PB));
        GSYNC();
        tail_fixup(E, S, (const float*)(ws + WS_PB));
    }
    GSYNC();
    {
        pg8::Gemm g{ACT, (const bf16_t*)(ws + WS_W2O), ROW_M, D, DFF}; pg8::StaticOrder S; S.init(ROW_M, D, DFF, G, bx, true);
        EpiResid E{p.out, HM, HB, SQ + 3 * MROWS, 0.5f, 0, nullptr, nullptr};
        pg8::gemm_phase(lds, g, S, E, (float*)(ws + WS_PB));
        GSYNC();
        tail_fixup(E, S, (const float*)(ws + WS_PB));
    }
    GSYNC();
    final_norm_phase(p);
}

constexpr int LDS_BYTES = pg8::STAGE_BYTES + 16;

extern "C" void kernel_launch(void* const* d_in, const int* in_sizes, int n_in, void* d_out, int out_size, void* d_ws, size_t ws_size, hipStream_t stream) {
    static int grid = 0;
    if (grid == 0) {
        if (n_in != 20 || ws_size < WS_END) { fprintf(stderr, "kernel_launch: unexpected inputs (%d) or workspace (%zu < %zu)\n", n_in, ws_size, (size_t)WS_END); grid = -1; return; }
        int dev = 0, cus = 0, per_cu = 0;
        hipGetDevice(&dev);
        hipDeviceGetAttribute(&cus, hipDeviceAttributeMultiprocessorCount, dev);
        hipFuncSetAttribute((const void*)hymba_fwd, hipFuncAttributeMaxDynamicSharedMemorySize, LDS_BYTES);
        hipOccupancyMaxActiveBlocksPerMultiprocessor(&per_cu, (const void*)hymba_fwd, NTHREADS, LDS_BYTES);
        if (per_cu < 1) per_cu = 1;
        (void)hipGetLastError();
        grid = cus;
    }
    if (grid < 0) return;
    Params p{};
    for (int i = 0; i < 20; ++i) p.in[i] = (const float*)d_in[i];
    p.out = (float*)d_out; p.ws = (unsigned char*)d_ws;
    void* args[] = {&p};
    (void)hipMemsetAsync((unsigned char*)d_ws + WS_BAR, 0, XCD_BAR_WORDS * 4, stream);
    hipError_t e = hipLaunchCooperativeKernel((const void*)hymba_fwd, dim3(grid), dim3(NTHREADS), args, LDS_BYTES, stream);
    if (e != hipSuccess) fprintf(stderr, "cooperative launch failed: %s (grid %d)\n", hipGetErrorString(e), grid);
}
```
